# Optimizing an MI355X kernel written in HIP

```python
import math
import jax, jax.numpy as jnp
from jax import lax
import numpy as np

D_MODEL = 1024
BATCH = 4
SEQ = 8192
DEPTH = 4

GRID_W = 64
CTX_LEN = 256
Q_BLOCK = 128
ROPE_THETA = 10000.0
NORM_EPS = 1e-6
MLA_HEADS = 8
MLA_Q_LORA = 384
MLA_KV_LORA = 256
MLA_NOPE = 64
MLA_ROPE = 32
MLA_V = 64
MLA_SCALE = (MLA_NOPE + MLA_ROPE) ** -0.5
GQA_HEADS = 8
GQA_KV_HEADS = 2
GQA_GROUP = GQA_HEADS // GQA_KV_HEADS
GQA_HEAD_DIM = 64
GQA_SCALE = GQA_HEAD_DIM ** -0.5
FFN_DENSE = 2816
N_EXPERTS = 8
TOP_K = 2
FFN_EXPERT = 3584
N_DENSE = (DEPTH + 1) // 2
N_MOE = DEPTH // 2
IN_SIZES = (MLA_Q_LORA, MLA_KV_LORA, MLA_ROPE,
            GQA_HEADS * GQA_HEAD_DIM, GQA_KV_HEADS * GQA_HEAD_DIM, GQA_KV_HEADS * GQA_HEAD_DIM,
            D_MODEL, D_MODEL)
D_IN = sum(IN_SIZES)

kernel_name = 'hybrid_mla_gqa_moe_prefix_ctx_trunk'


def rms_norm(x, g):
    xf = x.astype(jnp.float32)
    y = xf * lax.rsqrt(jnp.mean(xf * xf, axis=-1, keepdims=True) + NORM_EPS)
    return (y * g.astype(jnp.float32)).astype(x.dtype)


def modulate(h, shift, scale):
    return h * (1 + scale) + shift


def split_cols(y, sizes):
    offs, s = [], 0
    for n in sizes[:-1]:
        s += n
        offs.append(s)
    return jnp.split(y, offs, axis=-1)


def axial_rope_tables(n_ctx, n_lat, dim):
    half = dim // 2
    inv = ROPE_THETA ** (-(jnp.arange(half // 2, dtype=jnp.float32) * 2.0) / half)
    rows = n_lat // GRID_W
    t = jnp.arange(rows * GRID_W)
    row = (t // GRID_W).astype(jnp.float32)
    col = (t % GRID_W).astype(jnp.float32)
    zeros = jnp.zeros((n_ctx, half // 2), jnp.float32)
    ang_r = jnp.concatenate([zeros, row[:, None] * inv], axis=0)[:, None, :]
    ang_c = jnp.concatenate([zeros, col[:, None] * inv], axis=0)[:, None, :]
    return (jnp.cos(ang_r), jnp.sin(ang_r), jnp.cos(ang_c), jnp.sin(ang_c))


def _rotate(xa, cos, sin):
    x1, x2 = jnp.split(xa, 2, axis=-1)
    cos = cos.astype(xa.dtype)
    sin = sin.astype(xa.dtype)
    return jnp.concatenate([x1 * cos - x2 * sin, x1 * sin + x2 * cos], axis=-1)


def rope_2d(x, tabs):
    cos_r, sin_r, cos_c, sin_c = tabs
    half = x.shape[-1] // 2
    return jnp.concatenate([_rotate(x[..., :half], cos_r, sin_r),
                            _rotate(x[..., half:], cos_c, sin_c)], axis=-1)


def attn_blocks(q, k, v, scale):
    b, s, kh, g, dk = q.shape
    nb = s // Q_BLOCK
    qb = jnp.moveaxis(q.reshape(b, nb, Q_BLOCK, kh, g, dk), 1, 0)

    def one_block(q_blk):
        logits = jnp.einsum('bqhgd,bkhd->bhgqk', q_blk, k,
                            preferred_element_type=jnp.float32) * scale
        p = jax.nn.softmax(logits, axis=-1).astype(v.dtype)
        return jnp.einsum('bhgqk,bkhe->bqhge', p, v)

    out = lax.map(one_block, qb)
    return jnp.moveaxis(out, 0, 1).reshape(b, s, kh * g, v.shape[-1])


def attend(q, k, v, n_ctx, latent_only, scale):
    lat = attn_blocks(q[:, n_ctx:], k, v, scale)
    if latent_only:
        return lat
    ctx_out = attn_blocks(q[:, :n_ctx], k[:, :n_ctx], v[:, :n_ctx], scale)
    return jnp.concatenate([ctx_out, lat], axis=1)


def token_mixer(h, n_ctx, latent_only, w_in, q_norm_g, w_qb, kv_norm_g, w_kvb,
                gqa_q_g, gqa_k_g, w_o_mla, w_o_gqa, w_out, tabs_mla, tabs_gqa):
    b, t, _ = h.shape
    q_c, kv_c, k_pe, q_g, k_g, v_g, gate_mla, gate_gqa = split_cols(h @ w_in, IN_SIZES)

    q = (rms_norm(q_c, q_norm_g) @ w_qb).reshape(b, t, MLA_HEADS, MLA_NOPE + MLA_ROPE)
    q = jnp.concatenate([q[..., :MLA_NOPE], rope_2d(q[..., MLA_NOPE:], tabs_mla)], axis=-1)
    kv = (rms_norm(kv_c, kv_norm_g) @ w_kvb).reshape(b, t, MLA_HEADS, MLA_NOPE + MLA_V)
    k_pe = rope_2d(k_pe[:, :, None, :], tabs_mla)
    k = jnp.concatenate([kv[..., :MLA_NOPE],
                         jnp.broadcast_to(k_pe, (b, t, MLA_HEADS, MLA_ROPE))], axis=-1)
    v = kv[..., MLA_NOPE:]

    qg = rope_2d(rms_norm(q_g.reshape(b, t, GQA_HEADS, GQA_HEAD_DIM), gqa_q_g), tabs_gqa)
    qg = qg.reshape(b, t, GQA_KV_HEADS, GQA_GROUP, GQA_HEAD_DIM)
    kg = rope_2d(rms_norm(k_g.reshape(b, t, GQA_KV_HEADS, GQA_HEAD_DIM), gqa_k_g), tabs_gqa)
    vg = v_g.reshape(b, t, GQA_KV_HEADS, GQA_HEAD_DIM)

    start = n_ctx if latent_only else 0
    t_out = t - start
    o_mla = attend(q[:, :, :, None, :], k, v, n_ctx, latent_only, MLA_SCALE)
    o_mla = o_mla.reshape(b, t_out, MLA_HEADS * MLA_V) @ w_o_mla
    o_gqa = attend(qg, kg, vg, n_ctx, latent_only, GQA_SCALE)
    o_gqa = o_gqa.reshape(b, t_out, GQA_HEADS * GQA_HEAD_DIM) @ w_o_gqa

    merged = (jax.nn.sigmoid(gate_mla[:, start:]) * o_mla
              + jax.nn.sigmoid(gate_gqa[:, start:]) * o_gqa)
    return merged @ w_out


def swiglu(h, w1, w3, w2):
    return (jax.nn.silu(h @ w1) * (h @ w3)) @ w2


def moe_swiglu(h, router, w1, w3, w2):
    logits = (h @ router).astype(jnp.float32)
    top_val, top_idx = lax.top_k(logits, TOP_K)
    top_w = jax.nn.softmax(top_val, axis=-1)
    combine = jnp.sum(jax.nn.one_hot(top_idx, N_EXPERTS, dtype=jnp.float32) * top_w[..., None],
                      axis=-2).astype(h.dtype)
    y = jnp.zeros_like(h)
    for e in range(N_EXPERTS):
        y = y + combine[..., e:e + 1] * swiglu(h, w1[e], w3[e], w2[e])
    return y


def setup_inputs(seed: int = 0) -> dict:
    key = jax.random.key(seed)
    k = jax.random.split(key, 32)
    f32 = jnp.float32

    def w(i, shape, fan_in, s=1.0):
        return jax.random.normal(k[i], shape, f32) * (s * fan_in ** -0.5)

    def gain(i, shape):
        return 1.0 + 0.1 * jax.random.normal(k[i], shape, f32)

    D = D_MODEL
    return {
        'x': jax.random.normal(k[0], (BATCH, SEQ, D), f32),
        'c': jax.random.normal(k[1], (BATCH, D), f32),
        'ctx': jax.random.normal(k[2], (BATCH, CTX_LEN, D), f32),
        'c_ctx': jax.random.normal(k[3], (D,), f32),
        'w_ada': w(4, (DEPTH, D, 6 * D), D, 0.5),
        'b_ada': 0.1 * jax.random.normal(k[5], (DEPTH, 6 * D), f32),
        'norm1_g': gain(6, (DEPTH, D)),
        'norm2_g': gain(7, (DEPTH, D)),
        'w_in': w(8, (DEPTH, D, D_IN), D),
        'mla_q_norm_g': gain(9, (DEPTH, MLA_Q_LORA)),
        'mla_w_qb': w(10, (DEPTH, MLA_Q_LORA, MLA_HEADS * (MLA_NOPE + MLA_ROPE)), MLA_Q_LORA),
        'mla_kv_norm_g': gain(11, (DEPTH, MLA_KV_LORA)),
        'mla_w_kvb': w(12, (DEPTH, MLA_KV_LORA, MLA_HEADS * (MLA_NOPE + MLA_V)), MLA_KV_LORA),
        'gqa_q_norm_g': gain(13, (DEPTH, GQA_HEAD_DIM)),
        'gqa_k_norm_g': gain(14, (DEPTH, GQA_HEAD_DIM)),
        'w_o_mla': w(15, (DEPTH, MLA_HEADS * MLA_V, D), MLA_HEADS * MLA_V),
        'w_o_gqa': w(16, (DEPTH, GQA_HEADS * GQA_HEAD_DIM, D), GQA_HEADS * GQA_HEAD_DIM),
        'w_out': w(17, (DEPTH, D, D), D),
        'dense_w1': w(18, (N_DENSE, D, FFN_DENSE), D),
        'dense_w3': w(19, (N_DENSE, D, FFN_DENSE), D),
        'dense_w2': w(20, (N_DENSE, FFN_DENSE, D), FFN_DENSE),
        'moe_router': w(21, (N_MOE, D, N_EXPERTS), D),
        'moe_w1': w(22, (N_MOE, N_EXPERTS, D, FFN_EXPERT), D),
        'moe_w3': w(23, (N_MOE, N_EXPERTS, D, FFN_EXPERT), D),
        'moe_w2': w(24, (N_MOE, N_EXPERTS, FFN_EXPERT, D), FFN_EXPERT),
        'final_norm_g': gain(25, (D,)),
    }


def reference(x, c, ctx, c_ctx, w_ada, b_ada, norm1_g, norm2_g, w_in,
              mla_q_norm_g, mla_w_qb, mla_kv_norm_g, mla_w_kvb,
              gqa_q_norm_g, gqa_k_norm_g, w_o_mla, w_o_gqa, w_out,
              dense_w1, dense_w3, dense_w2, moe_router, moe_w1, moe_w3, moe_w2,
              final_norm_g):
    b, n_lat, d = x.shape
    n_ctx = ctx.shape[1]
    tabs_mla = axial_rope_tables(n_ctx, n_lat, MLA_ROPE)
    tabs_gqa = axial_rope_tables(n_ctx, n_lat, GQA_HEAD_DIM)
    silu_c = jax.nn.silu(c)
    silu_cc = jax.nn.silu(c_ctx)

    for l in range(DEPTH):
        last = l == DEPTH - 1
        mod_lat = (silu_c @ w_ada[l] + b_ada[l]).reshape(b, 1, 6, d)
        mod_ctx = (silu_cc @ w_ada[l] + b_ada[l]).reshape(1, 1, 6, d)
        sh1_l, sc1_l, g1_l, sh2_l, sc2_l, g2_l = [mod_lat[:, :, i] for i in range(6)]
        sh1_c, sc1_c, g1_c, sh2_c, sc2_c, g2_c = [mod_ctx[:, :, i] for i in range(6)]

        h = jnp.concatenate([modulate(rms_norm(ctx, norm1_g[l]), sh1_c, sc1_c),
                             modulate(rms_norm(x, norm1_g[l]), sh1_l, sc1_l)], axis=1)
        mix = token_mixer(h, n_ctx, last, w_in[l], mla_q_norm_g[l], mla_w_qb[l],
                          mla_kv_norm_g[l], mla_w_kvb[l], gqa_q_norm_g[l], gqa_k_norm_g[l],
                          w_o_mla[l], w_o_gqa[l], w_out[l], tabs_mla, tabs_gqa)
        x = x + g1_l * mix[:, -n_lat:]
        if not last:
            ctx = ctx + g1_c * mix[:, :n_ctx]

        h2_lat = modulate(rms_norm(x, norm2_g[l]), sh2_l, sc2_l)
        if last:
            h2 = h2_lat
        else:
            h2 = jnp.concatenate([modulate(rms_norm(ctx, norm2_g[l]), sh2_c, sc2_c), h2_lat], axis=1)
        if l % 2 == 0:
            f = swiglu(h2, dense_w1[l // 2], dense_w3[l // 2], dense_w2[l // 2])
        else:
            f = moe_swiglu(h2, moe_router[l // 2], moe_w1[l // 2], moe_w3[l // 2], moe_w2[l // 2])
        x = x + g2_l * f[:, -n_lat:]
        if not last:
            ctx = ctx + g2_c * f[:, :n_ctx]

    return rms_norm(x, final_norm_g)
```

```cpp
#include <hip/hip_runtime.h>
#include <cstdio>
#include <cstdint>
#include <cmath>

#ifndef MK_MULTI
#define MK_MULTI 0
#endif

#define LAS __attribute__((address_space(3)))
#define GAS __attribute__((address_space(1)))
typedef unsigned short bf16_t;
typedef short bf16x8 __attribute__((ext_vector_type(8)));
typedef short s16x4 __attribute__((ext_vector_type(4)));
typedef float f32x2 __attribute__((ext_vector_type(2)));
typedef float f32x4 __attribute__((ext_vector_type(4)));
typedef float f32x16 __attribute__((ext_vector_type(16)));
typedef unsigned u32x2 __attribute__((ext_vector_type(2)));
typedef unsigned u32x4 __attribute__((ext_vector_type(4)));
typedef int i32x2 __attribute__((ext_vector_type(2)));

constexpr int D = 1024, NB = 4, SEQ = 8192, NCTX = 256, TPB = SEQ + NCTX  , T = NB * TPB  , DEPTH = 4;
constexpr int PPB = TPB / 256;
constexpr int DINP = 3584;
constexpr int C_QC = 0, C_KVC = 384, C_KPE = 640, C_QG = 768, C_KG = 1280, C_VG = 1408, C_GM = 1536, C_GG = 2560;
constexpr int FD = 2816, FE = 3584, NE = 8;
constexpr float EPS = 1e-6f;
constexpr float LOG2E = 1.4426950408889634f;
constexpr int MOE_CH = 64;
constexpr int MOE_NCH = 5;
constexpr int MAXPAN = 272;

constexpr size_t MiB = 1u << 20;
constexpr size_t WS_CTL = 0, CTL_ZERO_BYTES = 2 * MiB;
constexpr size_t WS_ROPE_MLA = 2 * MiB, WS_ROPE_GQA = 2 * MiB + 16384, WS_MOD = 2 * MiB + 65536;
constexpr size_t WS_CNTB = 3 * MiB, WS_META = 3 * MiB + 65536;
constexpr size_t WS_TOK_E = 4 * MiB, WS_TOK_POS = 4 * MiB + 512 * 1024, WS_TOK_W = 5 * MiB, WS_TOK_SLOT = 5 * MiB + 512 * 1024;
constexpr size_t WS_WSM = 8 * MiB;
constexpr size_t SZ_WIN = (size_t)DINP * D * 2, SZ_WQB = 768 * 384 * 2, SZ_WKVB = 1024 * 384 * 2  , SZ_WO = 1024 * 512 * 2, SZ_WOUT = 1024 * 1024 * 2;
constexpr size_t OFF_WIN = 0, OFF_WQB = OFF_WIN + SZ_WIN, OFF_WKVB = OFF_WQB + SZ_WQB, OFF_WOM = OFF_WKVB + SZ_WKVB, OFF_WOG = OFF_WOM + SZ_WO, OFF_WOUT = OFF_WOG + SZ_WO, LW = OFF_WOUT + SZ_WOUT;
constexpr size_t WS_WDEN = 58 * MiB, SZ_W13D = (size_t)2 * FD * D * 2, SZ_W2D = (size_t)D * FD * 2, LWD = SZ_W13D + SZ_W2D;
constexpr size_t WS_WMOE13 = 92 * MiB, WS_WMOE2 = 204 * MiB;
constexpr size_t WS_XR = 260 * MiB;
constexpr size_t WS_BIG = 392 * MiB;
constexpr size_t WS_H = WS_BIG, WS_OM = WS_BIG, WS_OG = WS_BIG + 33 * MiB;
constexpr size_t WS_Y = WS_BIG + 66 * MiB;
constexpr size_t WS_QM = WS_BIG + 297 * MiB, WS_KM = WS_QM + (size_t)T * 768 * 2, WS_VM = WS_KM + (size_t)T * 768 * 2, WS_MG = WS_QM;
constexpr size_t WS_HH = WS_BIG + 66 * MiB;
constexpr size_t WS_XG = WS_BIG + 66 * MiB, WS_HHG = WS_BIG + 202 * MiB, WS_YG = WS_BIG + 314 * MiB;
constexpr size_t WS_SSQ_Q = WS_BIG + 450 * MiB, WS_SSQ_KV = WS_SSQ_Q + 2 * MiB;
constexpr size_t WS_END = WS_BIG + 454 * MiB;
static_assert(WS_WSM + 4 * LW <= WS_WDEN && WS_WDEN + 2 * LWD <= WS_WMOE13, "small weights");
static_assert(WS_WMOE13 + (size_t)NE * 2 * FE * D * 2 <= WS_WMOE2 && WS_WMOE2 + (size_t)NE * D * FE * 2 <= WS_XR, "moe weights");
static_assert(WS_XR + (size_t)T * D * 4 <= WS_BIG, "xr");
static_assert(WS_H + (size_t)T * D * 2 <= WS_Y && WS_Y + (size_t)T * DINP * 2 <= WS_QM && WS_VM + (size_t)T * 512 * 2 <= WS_END, "attn stage");
static_assert(WS_HH + (size_t)T * FD * 2 <= WS_END, "dense stage");
static_assert(WS_XG + (size_t)MAXPAN * 256 * D * 2 <= WS_HHG && WS_HHG + (size_t)MOE_CH * 256 * FE * 2 <= WS_YG && WS_YG + (size_t)MAXPAN * 256 * D * 2 <= WS_END, "moe stage");
static_assert(WS_MOD + (size_t)DEPTH * 5 * 6 * D * 4 <= WS_CNTB, "mod");
constexpr int CW_BAR = 4096;

constexpr int RING_BYTES = 131072;
constexpr int LDSCTL_OFF = RING_BYTES;
constexpr int LDS_BYTES = 147456;

__device__ __forceinline__ unsigned cvt_pk_bf16(float lo, float hi) { unsigned r; asm volatile("v_cvt_pk_bf16_f32 %0, %1, %2" : "=v"(r) : "v"(lo), "v"(hi)); return r; }
__device__ __forceinline__ float bflo(unsigned w) { return __uint_as_float(w << 16); }
__device__ __forceinline__ float bfhi(unsigned w) { return __uint_as_float(w & 0xffff0000u); }
__device__ __forceinline__ float bf1(bf16_t h) { return __uint_as_float((unsigned)h << 16); }
__device__ __forceinline__ f32x4 bf4(u32x2 w) { return (f32x4){bflo(w.x), bfhi(w.x), bflo(w.y), bfhi(w.y)}; }
__device__ __forceinline__ float fast_sigmoid(float x) { return __builtin_amdgcn_rcpf(1.0f + __builtin_amdgcn_exp2f(-x * LOG2E)); }
template <int M> __device__ __forceinline__ float lane_xor(float v) {
    if constexpr (M == 32) { auto rr = __builtin_amdgcn_permlane32_swap(__float_as_uint(v), __float_as_uint(v), false, false); return __uint_as_float((threadIdx.x & 32) ? rr[0] : rr[1]); }
    else return __uint_as_float((unsigned)__builtin_amdgcn_ds_swizzle((int)__float_as_uint(v), (M << 10) | 0x1f));
}
__device__ __forceinline__ float wave_sum(float v) {
    v += lane_xor<1>(v); v += lane_xor<2>(v); v += lane_xor<4>(v); v += lane_xor<8>(v); v += lane_xor<16>(v);
    { auto rr = __builtin_amdgcn_permlane32_swap(__float_as_uint(v), __float_as_uint(v), false, false); v = __uint_as_float(rr[0]) + __uint_as_float(rr[1]); }
    return v;
}

namespace pg8 {
constexpr int BM = 256, BK = 64, HALF = 128, HTB = HALF * BK * 2, STAGE_BYTES = 8 * HTB, NXCD = 8, WGM = 8;
__host__ __device__ __forceinline__ int lds_byte(int r, int c) { const int st = (r >> 4) * 2 + (c >> 5), rr = r & 15, cc = c & 31, ob = rr * 64 + cc * 2; return st * 1024 + (ob ^ (((ob >> 9) & 1) << 5)); }
__host__ __device__ __forceinline__ void stage_rc(int b, int& R, int& C) { const int st = b / 1024, sb = b % 1024, swz = sb ^ (((sb >> 9) & 1) << 5); R = (st >> 1) * 16 + swz / 64; C = (st & 1) * 32 + (swz % 64) / 2; }
__host__ __device__ __forceinline__ int perm32(int rho) { const int n = rho >> 4, i = rho & 15; return 8 * (i >> 2) + 4 * n + (i & 3); }

struct Unit { int pa, pb, pm, pn; int nt = 0, aoff = 0; };
struct Gemm { const bf16_t* A; const bf16_t* Bt; int lda, ldb, K; };

__device__ __forceinline__ bool tile_order(long L, int nM, int nN, int& pm, int& pn) {
    const int nwg = nM * nN; if (L >= nwg) return false;
    int wgid = (int)L; { const int q = nwg / NXCD, r = nwg % NXCD, xcd = wgid % NXCD, off = wgid / NXCD; wgid = (xcd < r ? xcd * (q + 1) : r * (q + 1) + (xcd - r) * q) + off; }
    const int nig = WGM * nN, gid = wgid / nig, fm = gid * WGM, gsz = (nM - fm) < WGM ? (nM - fm) : WGM;
    pm = fm + ((wgid % nig) % gsz); pn = (wgid % nig) / gsz; return true;
}
struct StaticOrder {
    static constexpr bool PAIRED = false, VARK = false;
    int nM, nN, G, c; int latent_only = 0;
    __device__ __forceinline__ bool next(int i, Unit& u) const {
        int pm, pn; if (!tile_order((long)i * G + c, nM, nN, pm, pn)) return false;
        if (latent_only) pm += (pm >> 5) + 1;
        u.pa = pm; u.pb = pn; u.pm = pm; u.pn = pn; return true;
    }
};
struct MoeOrder {
    static constexpr bool PAIRED = false, VARK = false;
    int p0, np, nN, G, c, aoff; const int* pexp;
    __device__ __forceinline__ bool next(int i, Unit& u) const {
        if (np <= 0) return false;
        int pm, pn; if (!tile_order((long)i * G + c, np, nN, pm, pn)) return false;
        pm += p0; const int e = __builtin_amdgcn_readfirstlane(pexp[pm]);
        u.pa = pm - aoff; u.pb = e * nN + pn; u.pm = pm; u.pn = pn; return true;
    }
};

struct QKVOrder {
    static constexpr bool PAIRED = false, VARK = true;
    int nMq, nMk, G, c, aoff; int latent_q = 0;
    __device__ __forceinline__ bool next(int i, Unit& u) const {
        const long L = (long)i * G + c; const int nQ = nMq * 3; int pm, pn;
        if (L < nQ) { tile_order(L, nMq, 3, pm, pn); if (latent_q) pm += (pm >> 5) + 1; u.pa = pm; u.pb = pn; u.pm = pm; u.pn = pn; u.nt = 6; u.aoff = 0; return true; }
        if (!tile_order(L - nQ, nMk, 4, pm, pn)) return false;
        u.pa = pm; u.pb = 3 + pn; u.pm = pm; u.pn = pn; u.nt = 4; u.aoff = aoff; return true;
    }
};
struct PairOrder {
    static constexpr bool PAIRED = true, VARK = false;
    int nM, nN, G, c, dpa, dpb; int latent_only = 0;
    __device__ __forceinline__ bool next(int i, Unit& u) const {
        const int j = i >> 1, seg = i & 1; int pm, pn; if (!tile_order((long)j * G + c, nM, nN, pm, pn)) return false;
        if (latent_only) pm += (pm >> 5) + 1;
        u.pa = pm + seg * dpa; u.pb = pn + seg * dpb; u.pm = pm; u.pn = pn; return true;
    }
};

template <class Epi, class Sched, bool ALIGN_EPI, bool SP2>
__device__ __forceinline__ void gemm_phase(LAS unsigned char* lds, const Gemm g, const Sched& S, const Epi& E, const int tid) {
    const int wid = __builtin_amdgcn_readfirstlane(tid >> 6), lane = tid & 63, wr = wid >> 2, wc = wid & 3, fr = lane & 15, fq = lane >> 4;
    const int K = g.K, nt = K / BK;
    unsigned voffA[2], voffB[2];
#pragma unroll
    for (int i = 0; i < 2; ++i) { int R, C; stage_rc(tid * 16 + i * 8192, R, C); const int Rb = Epi::PERM ? ((R & ~31) + perm32(R & 31)) : R;
        voffA[i] = (unsigned)(R * g.lda + C) * 2u; voffB[i] = (unsigned)(Rb * g.ldb + C) * 2u; }
    const size_t kstep = (size_t)(BK * 2);
    const size_t hstepA = (size_t)HALF * g.lda * 2, hstepB = (size_t)HALF * g.ldb * 2;
    const size_t tstepA = 2 * hstepA, tstepB = 2 * hstepB;
    const unsigned ldsw = (unsigned)wid * 1024u;
    const int aoff = lds_byte(wr * 64 + fr, fq * 8), boff = lds_byte(wc * 32 + fr, fq * 8);
#define PG8_SA(b, h) (((b) * 2 + (h)) * HTB)
#define PG8_SB(b, h) ((4 + (b) * 2 + (h)) * HTB)
#define PG8_STAGE(bufoff, gbase, voff) do { _Pragma("unroll") for (int _i = 0; _i < 2; ++_i) \
        __builtin_amdgcn_global_load_lds((const unsigned*)((const char*)(gbase) + (voff)[_i]), (LAS unsigned*)(lds + (bufoff) + ldsw + _i * 8192), 16, 0, 0); } while (0)
#define PG8_LDA(dst, b, h) do { _Pragma("unroll") for (int m = 0; m < 4; ++m) _Pragma("unroll") for (int k = 0; k < 2; ++k) dst[m][k] = *(const LAS bf16x8*)(lds + PG8_SA(b, h) + aoff + m * 2048 + k * 1024); } while (0)
#define PG8_LDB(dst, b, h) do { _Pragma("unroll") for (int n = 0; n < 2; ++n) _Pragma("unroll") for (int k = 0; k < 2; ++k) dst[n][k] = *(const LAS bf16x8*)(lds + PG8_SB(b, h) + boff + n * 2048 + k * 1024); } while (0)
#define PG8_MMA(ai, bj, At, Bt) do { __builtin_amdgcn_s_setprio(1); _Pragma("unroll") for (int m = 0; m < 4; ++m) _Pragma("unroll") for (int n = 0; n < 2; ++n) _Pragma("unroll") for (int k = 0; k < 2; ++k) \
        acc[ai][bj][m][n] = __builtin_amdgcn_mfma_f32_16x16x32_bf16(Bt[n][k], At[m][k], acc[ai][bj][m][n], 0, 0, 0); __builtin_amdgcn_s_setprio(0); } while (0)
#define PG8_WAIT_V(n) asm volatile("s_waitcnt vmcnt(" #n ")" ::: "memory")
#define PG8_WAIT_L(n) asm volatile("s_waitcnt lgkmcnt(" #n ")" ::: "memory")
#define PG8_BAR __builtin_amdgcn_s_barrier()
#define PG8_SCHED __builtin_amdgcn_sched_barrier(0)
    Unit cur, nxt; int ui = 0;
    if (!S.next(0, cur)) return;
    f32x4 acc[2][2][4][2];
#pragma unroll
    for (int a = 0; a < 2; ++a)
#pragma unroll
        for (int b = 0; b < 2; ++b)
#pragma unroll
            for (int m = 0; m < 4; ++m)
#pragma unroll
                for (int n = 0; n < 2; ++n) acc[a][b][m][n] = (f32x4){0.f, 0.f, 0.f, 0.f};
    bf16x8 At[4][2], B0[2][2], B1[2][2];
    const char* cA = (const char*)g.A + (size_t)cur.pa * tstepA; const char* cB = (const char*)g.Bt + (size_t)cur.pb * tstepB;
    if constexpr (Sched::VARK) cA += cur.aoff;
    if constexpr (SP2) {
        PG8_STAGE(PG8_SB(0, 0), cB, voffB); PG8_STAGE(PG8_SB(0, 1), cB + hstepB, voffB); PG8_STAGE(PG8_SA(0, 0), cA, voffA); PG8_STAGE(PG8_SA(0, 1), cA + hstepA, voffA);
        if (wr == 1) PG8_BAR;
        PG8_WAIT_V(2); PG8_BAR;
        PG8_STAGE(PG8_SB(1, 0), cB + kstep, voffB); PG8_STAGE(PG8_SA(1, 0), cA + kstep, voffA); PG8_STAGE(PG8_SB(1, 1), cB + hstepB + kstep, voffB);
        PG8_WAIT_V(6); PG8_BAR;
    } else {
        PG8_STAGE(PG8_SB(0, 0), cB, voffB); PG8_STAGE(PG8_SA(0, 0), cA, voffA); PG8_STAGE(PG8_SB(0, 1), cB + hstepB, voffB); PG8_STAGE(PG8_SA(0, 1), cA + hstepA, voffA);
        if (wr == 1) PG8_BAR;
        PG8_WAIT_V(4); PG8_BAR;
        PG8_STAGE(PG8_SB(1, 0), cB + kstep, voffB); PG8_STAGE(PG8_SA(1, 0), cA + kstep, voffA); PG8_STAGE(PG8_SB(1, 1), cB + hstepB + kstep, voffB);
        PG8_WAIT_V(6); PG8_BAR;
    }
    for (;;) {
        const bool has_next = S.next(ui + 1, nxt);
        const char* nA = has_next ? (const char*)g.A + (size_t)nxt.pa * tstepA : cA; const char* nB = has_next ? (const char*)g.Bt + (size_t)nxt.pb * tstepB : cB;
        int ntu = nt;
        if constexpr (Sched::VARK) { if (has_next) nA += nxt.aoff; ntu = cur.nt; }
#pragma clang loop unroll(disable)
        for (int t = 0; t < ntu; t += 2) {
            const bool last = (t == ntu - 2);
            const char* a1 = cA + (size_t)(t + 1) * kstep;
            const char* a2 = last ? nA : cA + (size_t)(t + 2) * kstep; const char* b2 = last ? nB : cB + (size_t)(t + 2) * kstep;
            const char* a3 = a2 + kstep; const char* b3 = b2 + kstep;
            if constexpr (SP2) {
            PG8_LDB(B0, 0, 0); PG8_LDB(B1, 0, 1); PG8_SCHED; PG8_LDA(At, 0, 0); PG8_STAGE(PG8_SA(1, 1), a1 + hstepA, voffA);
            PG8_WAIT_V(8); PG8_WAIT_L(0); PG8_BAR; PG8_MMA(0, 0, At, B0); PG8_MMA(0, 1, At, B1); PG8_BAR; PG8_SCHED;
            PG8_LDA(At, 0, 1); PG8_STAGE(PG8_SB(0, 0), b2, voffB); PG8_STAGE(PG8_SB(0, 1), b2 + hstepB, voffB); PG8_STAGE(PG8_SA(0, 0), a2, voffA);
            PG8_WAIT_V(8); PG8_WAIT_L(0); PG8_BAR; PG8_MMA(1, 0, At, B0); PG8_MMA(1, 1, At, B1); PG8_BAR; PG8_SCHED;
            PG8_LDB(B0, 1, 0); PG8_LDB(B1, 1, 1); PG8_SCHED; PG8_LDA(At, 1, 0); PG8_STAGE(PG8_SA(0, 1), a2 + hstepA, voffA);
            PG8_WAIT_V(8); PG8_WAIT_L(0); PG8_BAR; PG8_MMA(0, 0, At, B0); PG8_MMA(0, 1, At, B1); PG8_BAR; PG8_SCHED;
            PG8_LDA(At, 1, 1); PG8_STAGE(PG8_SB(1, 0), b3, voffB); PG8_STAGE(PG8_SB(1, 1), b3 + hstepB, voffB); PG8_STAGE(PG8_SA(1, 0), a3, voffA);
            PG8_WAIT_V(8); PG8_WAIT_L(0); PG8_BAR; PG8_MMA(1, 0, At, B0); PG8_MMA(1, 1, At, B1); PG8_BAR; PG8_SCHED;
            } else {
            PG8_LDB(B0, 0, 0); PG8_SCHED; PG8_LDA(At, 0, 0); PG8_STAGE(PG8_SA(1, 1), a1 + hstepA, voffA);
            PG8_WAIT_L(8); PG8_BAR; PG8_WAIT_L(0); PG8_MMA(0, 0, At, B0); PG8_BAR; PG8_SCHED;
            PG8_LDB(B1, 0, 1); PG8_STAGE(PG8_SB(0, 0), b2, voffB);
            PG8_BAR; PG8_WAIT_L(0); PG8_MMA(0, 1, At, B1); PG8_BAR;
            PG8_LDA(At, 0, 1); PG8_STAGE(PG8_SA(0, 0), a2, voffA);
            PG8_BAR; PG8_WAIT_L(0); PG8_MMA(1, 0, At, B0); PG8_BAR; PG8_SCHED;
            PG8_STAGE(PG8_SB(0, 1), b2 + hstepB, voffB);
            PG8_WAIT_V(6); PG8_BAR; PG8_MMA(1, 1, At, B1); PG8_BAR;
            PG8_LDB(B0, 1, 0); PG8_SCHED; PG8_LDA(At, 1, 0); PG8_STAGE(PG8_SA(0, 1), a2 + hstepA, voffA);
            PG8_WAIT_L(8); PG8_BAR; PG8_WAIT_L(0); PG8_MMA(0, 0, At, B0); PG8_BAR; PG8_SCHED;
            PG8_LDB(B1, 1, 1); PG8_STAGE(PG8_SB(1, 0), b3, voffB);
            PG8_BAR; PG8_WAIT_L(0); PG8_MMA(0, 1, At, B1); PG8_BAR;
            PG8_LDA(At, 1, 1); PG8_STAGE(PG8_SA(1, 0), a3, voffA);
            PG8_BAR; PG8_WAIT_L(0); PG8_MMA(1, 0, At, B0); PG8_BAR; PG8_SCHED;
            PG8_STAGE(PG8_SB(1, 1), b3 + hstepB, voffB);
            PG8_WAIT_V(6); PG8_BAR; PG8_MMA(1, 1, At, B1); PG8_BAR;
            }
        }
        if constexpr (ALIGN_EPI) { if (wr == 0) PG8_BAR; }
        bool fin = true;
        if constexpr (Sched::PAIRED) { fin = (cur.pa != cur.pm); if (fin) E(acc, cur, wr, wc, fr, fq); else E.mid(acc, cur, wr, wc, fr, fq); }
        else E(acc, cur, wr, wc, fr, fq);
        if (!has_next) break;
        if (fin) {
#pragma unroll
        for (int a = 0; a < 2; ++a)
#pragma unroll
            for (int b = 0; b < 2; ++b)
#pragma unroll
                for (int m = 0; m < 4; ++m)
#pragma unroll
                    for (int n = 0; n < 2; ++n) acc[a][b][m][n] = (f32x4){0.f, 0.f, 0.f, 0.f};
        }
        cur = nxt; cA = nA; cB = nB; ++ui;
        if constexpr (ALIGN_EPI) { if (wr == 1) PG8_BAR; }
    }
    PG8_WAIT_V(0);
    if constexpr (!ALIGN_EPI) { if (wr == 0) PG8_BAR; }
    PG8_BAR;
#undef PG8_SA
#undef PG8_SB
#undef PG8_STAGE
#undef PG8_LDA
#undef PG8_LDB
#undef PG8_MMA
#undef PG8_WAIT_V
#undef PG8_WAIT_L
#undef PG8_BAR
#undef PG8_SCHED
}

__device__ __forceinline__ u32x4 pack8(const f32x4 v0, const f32x4 v1) {
    u32x4 w; w.x = cvt_pk_bf16(v0[0], v0[1]); w.y = cvt_pk_bf16(v0[2], v0[3]); w.z = cvt_pk_bf16(v1[0], v1[1]); w.w = cvt_pk_bf16(v1[2], v1[3]); return w;
}
struct EpiBf16 {
    static constexpr bool PERM = true;
    bf16_t* O; int ldc; int sig_from; int prow_off;
    __device__ __forceinline__ void operator()(const f32x4 (&acc)[2][2][4][2], const Unit& u, int wr, int wc, int fr, int fq) const {
        const int row0 = (u.pm - prow_off) * BM + wr * 64 + fr, col0 = u.pn * BM + wc * 32 + 8 * fq;
#pragma unroll
        for (int ai = 0; ai < 2; ++ai)
#pragma unroll
            for (int m = 0; m < 4; ++m) { bf16_t* rowp = O + (size_t)(row0 + ai * HALF + m * 16) * ldc + col0;
#pragma unroll
                for (int bj = 0; bj < 2; ++bj) { f32x4 v0 = acc[ai][bj][m][0], v1 = acc[ai][bj][m][1];
                    if (col0 + bj * HALF >= sig_from) {
#pragma unroll
                        for (int q = 0; q < 4; ++q) { v0[q] = fast_sigmoid(v0[q]); v1[q] = fast_sigmoid(v1[q]); } }
                    *(u32x4*)(rowp + bj * HALF) = pack8(v0, v1); } }
    }
};
struct EpiIn {
    static constexpr bool PERM = true;
    bf16_t* O; float* ssq_q; float* ssq_kv; bf16_t* Km; const float* rope_m; const float* rope_g; const float* gq; const float* gk;
    __device__ __forceinline__ void operator()(const f32x4 (&acc)[2][2][4][2], const Unit& u, int wr, int wc, int fr, int fq) const {
        const int row0 = u.pm * BM + wr * 64 + fr, col0 = u.pn * BM + wc * 32 + 8 * fq;
        const int tp = u.pm % PPB; const bool rot = tp != 0;
        const bool isq = u.pn < 5, ishead = (u.pn == 3) || (u.pn == 4) || (u.pn == 5 && wc < 2), isv = (u.pn == 5 && wc >= 2), gate = u.pn >= 6, kpe = (u.pn == 2 && wc == 0);
        int cb0 = col0, cb1 = col0 + HALF;
        if (ishead) { const int head = isq ? 4 * (u.pn - 3) + wc : wc; cb0 = (isq ? C_QG : C_KG) + head * 64 + 8 * fq; cb1 = cb0 + 32; }
        if (isv) { cb0 = C_VG + (wc - 2) * 64 + 8 * fq; cb1 = cb0 + 32; }
        const float* gg = (isq ? gq : gk) + 8 * fq; const float qs = isq ? 0.125f * LOG2E : 1.0f;
        const int f0 = (fq & 1) * 8; const bool up = (fq & 2) != 0;
#pragma unroll
        for (int ai = 0; ai < 2; ++ai)
#pragma unroll
            for (int m = 0; m < 4; ++m) { const int row = row0 + ai * HALF + m * 16; bf16_t* rowp = O + (size_t)row * DINP;
                f32x4 v[2][2] = {{acc[ai][0][m][0], acc[ai][0][m][1]}, {acc[ai][1][m][0], acc[ai][1][m][1]}};
                const int grow = (tp - 1) * 4 + 2 * ai + wr, gcol = 16 * m + fr;
                if (u.pn < 3) {
                    float sq[2];
#pragma unroll
                    for (int bj = 0; bj < 2; ++bj) { const f32x4 a = v[bj][0], b = v[bj][1];
                        float t = (a[0] * a[0] + a[1] * a[1]) + (a[2] * a[2] + a[3] * a[3]) + (b[0] * b[0] + b[1] * b[1]) + (b[2] * b[2] + b[3] * b[3]);
                        t += lane_xor<16>(t); { auto rr = __builtin_amdgcn_permlane32_swap(__float_as_uint(t), __float_as_uint(t), false, false); t = __uint_as_float(rr[0]) + __uint_as_float(rr[1]); }
                        sq[bj] = t; }
                    if (fq == 0) {
                        if (u.pn == 0) ssq_q[(size_t)row * 8 + wc] = sq[0] + sq[1];
                        else if (u.pn == 1) { ssq_q[(size_t)row * 8 + 4 + wc] = sq[0]; ssq_kv[(size_t)row * 8 + wc] = sq[1]; }
                        else ssq_kv[(size_t)row * 8 + 4 + wc] = sq[0]; }
                    if (kpe) {
                        const int pos = (fq < 2) ? grow : gcol;
                        f32x4 c0 = (f32x4){1.f, 1.f, 1.f, 1.f}, c1 = c0, s0 = (f32x4){0.f, 0.f, 0.f, 0.f}, s1 = s0;
                        if (rot) { const f32x4* rp = (const f32x4*)(rope_m + pos * 16); c0 = rp[0]; c1 = rp[1]; s0 = rp[2]; s1 = rp[3]; }
                        if (!(fq & 1)) { s0 = -s0; s1 = -s1; }
                        f32x4 p0, p1;
#pragma unroll
                        for (int q = 0; q < 4; ++q) { p0[q] = lane_xor<16>(v[1][0][q]); p1[q] = lane_xor<16>(v[1][1][q]); }
                        const u32x4 ow = pack8(v[1][0] * c0 + p0 * s0, v[1][1] * c1 + p1 * s1);
#pragma unroll
                        for (int h = 0; h < 8; ++h) *(u32x4*)(Km + (size_t)row * 768 + h * 96 + 64 + 8 * fq) = ow; }
                }
                if (ishead) {
                    float ss = 0.f;
#pragma unroll
                    for (int bj = 0; bj < 2; ++bj)
#pragma unroll
                        for (int n = 0; n < 2; ++n) { const f32x4 x = v[bj][n]; ss += (x[0] * x[0] + x[1] * x[1]) + (x[2] * x[2] + x[3] * x[3]); }
                    ss += lane_xor<16>(ss); { auto rr = __builtin_amdgcn_permlane32_swap(__float_as_uint(ss), __float_as_uint(ss), false, false); ss = __uint_as_float(rr[0]) + __uint_as_float(rr[1]); }
                    const float rstd = 1.0f / sqrtf(ss * (1.0f / 64.0f) + EPS);
#pragma unroll
                    for (int bj = 0; bj < 2; ++bj) {
                        const f32x4 g0 = *(const f32x4*)(gg + 32 * bj), g1 = *(const f32x4*)(gg + 32 * bj + 4);
                        const f32x4 y0 = v[bj][0] * rstd * g0, y1 = v[bj][1] * rstd * g1;
                        f32x4 c0 = (f32x4){1.f, 1.f, 1.f, 1.f}, c1 = c0, s0 = (f32x4){0.f, 0.f, 0.f, 0.f}, s1 = s0;
                        if (rot) { const f32x4* rp = (const f32x4*)(rope_g + (bj ? gcol : grow) * 32 + f0); c0 = rp[0]; c1 = rp[1]; s0 = rp[4]; s1 = rp[5]; }
                        if (!up) { s0 = -s0; s1 = -s1; }
                        f32x4 p0, p1;
#pragma unroll
                        for (int q = 0; q < 4; ++q) {
                            { auto rr = __builtin_amdgcn_permlane32_swap(__float_as_uint(y0[q]), __float_as_uint(y0[q]), false, false); p0[q] = __uint_as_float(up ? rr[0] : rr[1]); }
                            { auto rr = __builtin_amdgcn_permlane32_swap(__float_as_uint(y1[q]), __float_as_uint(y1[q]), false, false); p1[q] = __uint_as_float(up ? rr[0] : rr[1]); } }
                        v[bj][0] = (y0 * c0 + p0 * s0) * qs; v[bj][1] = (y1 * c1 + p1 * s1) * qs; }
                }
                if (gate) {
#pragma unroll
                    for (int bj = 0; bj < 2; ++bj)
#pragma unroll
                        for (int q = 0; q < 4; ++q) { v[bj][0][q] = fast_sigmoid(v[bj][0][q]); v[bj][1][q] = fast_sigmoid(v[bj][1][q]); } }
                *(u32x4*)(rowp + cb0) = pack8(v[0][0], v[0][1]);
                *(u32x4*)(rowp + cb1) = pack8(v[1][0], v[1][1]);
            }
    }
};
struct EpiQ {
    static constexpr bool PERM = true; static constexpr float QSC = 0.10206207261596575f * LOG2E;
    bf16_t* Qm; const float* rope; const float* ssq;
    __device__ __forceinline__ float rstd_of(size_t row) const { const f32x4 a = *(const f32x4*)(ssq + row * 8), b = *(const f32x4*)(ssq + row * 8 + 4);
        return 1.0f / sqrtf(((a[0] + a[1]) + (a[2] + a[3]) + (b[0] + b[1]) + (b[2] + b[3])) * (1.0f / 384.0f) + EPS); }
    __device__ __forceinline__ void operator()(const f32x4 (&acc)[2][2][4][2], const Unit& u, int wr, int wc, int fr, int fq) const {
        const int row0 = u.pm * BM + wr * 64 + fr;
        if (u.pn < 2) {
#pragma unroll
            for (int bj = 0; bj < 2; ++bj) { const int c = u.pn * BM + bj * HALF + wc * 32 + 8 * fq, h = c >> 6, d = c & 63;
#pragma unroll
                for (int ai = 0; ai < 2; ++ai)
#pragma unroll
                    for (int m = 0; m < 4; ++m) { const size_t row = (size_t)(row0 + ai * HALF + m * 16); const float sc = QSC * rstd_of(row);
                        *(u32x4*)(Qm + row * 768 + h * 96 + d) = pack8(acc[ai][bj][m][0] * sc, acc[ai][bj][m][1] * sc); } }
        } else {
            const int tp = u.pm % PPB; const bool rot = tp != 0;
#pragma unroll
            for (int ai = 0; ai < 2; ++ai)
#pragma unroll
                for (int m = 0; m < 4; ++m) {
                    const int grow = (tp - 1) * 4 + 2 * ai + wr, gcol = 16 * m + fr, pos = (fq < 2) ? grow : gcol;
                    f32x4 c0 = (f32x4){1.f, 1.f, 1.f, 1.f}, c1 = c0, s0 = (f32x4){0.f, 0.f, 0.f, 0.f}, s1 = s0;
                    if (rot) { const f32x4* rp = (const f32x4*)(rope + pos * 16); c0 = rp[0]; c1 = rp[1]; s0 = rp[2]; s1 = rp[3]; }
                    const float sc = QSC * rstd_of((size_t)(row0 + ai * HALF + m * 16));
                    if (!(fq & 1)) { s0 = -s0; s1 = -s1; }
#pragma unroll
                    for (int bj = 0; bj < 2; ++bj) { const int h = 4 * bj + wc;
                        const f32x4 v0 = acc[ai][bj][m][0], v1 = acc[ai][bj][m][1]; f32x4 p0, p1;
#pragma unroll
                        for (int q = 0; q < 4; ++q) { p0[q] = lane_xor<16>(v0[q]); p1[q] = lane_xor<16>(v1[q]); }
                        const f32x4 o0 = (v0 * c0 + p0 * s0) * sc, o1 = (v1 * c1 + p1 * s1) * sc;
                        *(u32x4*)(Qm + (size_t)(row0 + ai * HALF + m * 16) * 768 + h * 96 + 64 + 8 * fq) = pack8(o0, o1); }
                    asm volatile("" ::: "memory"); __builtin_amdgcn_sched_barrier(0);
                }
        }
    }
};
struct EpiKV {
    static constexpr bool PERM = true;
    bf16_t* Km; bf16_t* Vm; const float* ssq;
    __device__ __forceinline__ void operator()(const f32x4 (&acc)[2][2][4][2], const Unit& u, int wr, int wc, int fr, int fq) const {
        const int row0 = u.pm * BM + wr * 64 + fr;
#pragma unroll
        for (int bj = 0; bj < 2; ++bj) { const int h = 2 * u.pn + bj, j = wc * 32 + 8 * fq;
            bf16_t* base = (j < 64) ? Km + h * 96 + j : Vm + h * 64 + (j - 64); const int ld = (j < 64) ? 768 : 512;
#pragma unroll
            for (int ai = 0; ai < 2; ++ai)
#pragma unroll
                for (int m = 0; m < 4; ++m) { const size_t row = (size_t)(row0 + ai * HALF + m * 16);
                    const f32x4 a = *(const f32x4*)(ssq + row * 8), b = *(const f32x4*)(ssq + row * 8 + 4);
                    const float sc = 1.0f / sqrtf(((a[0] + a[1]) + (a[2] + a[3]) + (b[0] + b[1]) + (b[2] + b[3])) * (1.0f / 256.0f) + EPS);
                    *(u32x4*)(base + row * ld) = pack8(acc[ai][bj][m][0] * sc, acc[ai][bj][m][1] * sc); } }
    }
};
struct EpiQKV {
    static constexpr bool PERM = true;
    EpiQ q; EpiKV kv;
    __device__ __forceinline__ void operator()(const f32x4 (&acc)[2][2][4][2], const Unit& u, int wr, int wc, int fr, int fq) const {
        if (u.pb < 3) q(acc, u, wr, wc, fr, fq); else kv(acc, u, wr, wc, fr, fq);
    }
};
struct EpiGate2 {
    static constexpr bool PERM = true;
    bf16_t* MG; const bf16_t* gm; const bf16_t* gg;
    __device__ __forceinline__ void mid(f32x4 (&acc)[2][2][4][2], const Unit& u, int wr, int wc, int fr, int fq) const {
        const int row0 = u.pm * BM + wr * 64 + fr, col0 = u.pn * BM + wc * 32 + 8 * fq;
#pragma unroll
        for (int ai = 0; ai < 2; ++ai)
#pragma unroll
            for (int m = 0; m < 4; ++m) { const size_t row = (size_t)(row0 + ai * HALF + m * 16);
#pragma unroll
                for (int bj = 0; bj < 2; ++bj) { const int c = col0 + bj * HALF;
                    const u32x4 a = *(const u32x4*)(gm + row * DINP + c), b = *(const u32x4*)(gg + row * DINP + c);
                    f32x4& v0 = acc[ai][bj][m][0]; f32x4& v1 = acc[ai][bj][m][1];
                    v0[0] *= bflo(a.x) * __builtin_amdgcn_rcpf(fmaxf(bflo(b.x), 1e-30f)); v0[1] *= bfhi(a.x) * __builtin_amdgcn_rcpf(fmaxf(bfhi(b.x), 1e-30f));
                    v0[2] *= bflo(a.y) * __builtin_amdgcn_rcpf(fmaxf(bflo(b.y), 1e-30f)); v0[3] *= bfhi(a.y) * __builtin_amdgcn_rcpf(fmaxf(bfhi(b.y), 1e-30f));
                    v1[0] *= bflo(a.z) * __builtin_amdgcn_rcpf(fmaxf(bflo(b.z), 1e-30f)); v1[1] *= bfhi(a.z) * __builtin_amdgcn_rcpf(fmaxf(bfhi(b.z), 1e-30f));
                    v1[2] *= bflo(a.w) * __builtin_amdgcn_rcpf(fmaxf(bflo(b.w), 1e-30f)); v1[3] *= bfhi(a.w) * __builtin_amdgcn_rcpf(fmaxf(bfhi(b.w), 1e-30f)); } }
    }
    __device__ __forceinline__ void operator()(const f32x4 (&acc)[2][2][4][2], const Unit& u, int wr, int wc, int fr, int fq) const {
        const int row0 = u.pm * BM + wr * 64 + fr, col0 = u.pn * BM + wc * 32 + 8 * fq;
#pragma unroll
        for (int ai = 0; ai < 2; ++ai)
#pragma unroll
            for (int m = 0; m < 4; ++m) { const size_t row = (size_t)(row0 + ai * HALF + m * 16);
#pragma unroll
                for (int bj = 0; bj < 2; ++bj) { const int c = col0 + bj * HALF;
                    const u32x4 gw = *(const u32x4*)(gg + row * DINP + c);
                    f32x4 v0 = acc[ai][bj][m][0], v1 = acc[ai][bj][m][1];
                    v0[0] *= bflo(gw.x); v0[1] *= bfhi(gw.x); v0[2] *= bflo(gw.y); v0[3] *= bfhi(gw.y);
                    v1[0] *= bflo(gw.z); v1[1] *= bfhi(gw.z); v1[2] *= bflo(gw.w); v1[3] *= bfhi(gw.w);
                    *(u32x4*)(MG + row * D + c) = pack8(v0, v1); } }
    }
};
template <bool ACCUM> struct EpiGate {
    static constexpr bool PERM = true;
    bf16_t* MG; const bf16_t* gate;
    __device__ __forceinline__ void operator()(const f32x4 (&acc)[2][2][4][2], const Unit& u, int wr, int wc, int fr, int fq) const {
        const int row0 = u.pm * BM + wr * 64 + fr, col0 = u.pn * BM + wc * 32 + 8 * fq;
#pragma unroll
        for (int ai = 0; ai < 2; ++ai)
#pragma unroll
            for (int m = 0; m < 4; ++m) { const size_t row = (size_t)(row0 + ai * HALF + m * 16);
#pragma unroll
                for (int bj = 0; bj < 2; ++bj) { const int c = col0 + bj * HALF;
                    const u32x4 gw = *(const u32x4*)(gate + row * DINP + c);
                    f32x4 v0 = acc[ai][bj][m][0], v1 = acc[ai][bj][m][1];
                    v0[0] *= bflo(gw.x); v0[1] *= bfhi(gw.x); v0[2] *= bflo(gw.y); v0[3] *= bfhi(gw.y);
                    v1[0] *= bflo(gw.z); v1[1] *= bfhi(gw.z); v1[2] *= bflo(gw.w); v1[3] *= bfhi(gw.w);
                    if (ACCUM) { const u32x4 ow = *(const u32x4*)(MG + row * D + c);
                        v0[0] += bflo(ow.x); v0[1] += bfhi(ow.x); v0[2] += bflo(ow.y); v0[3] += bfhi(ow.y);
                        v1[0] += bflo(ow.z); v1[1] += bfhi(ow.z); v1[2] += bflo(ow.w); v1[3] += bfhi(ow.w); }
                    *(u32x4*)(MG + row * D + c) = pack8(v0, v1); } }
    }
};
struct EpiRes {
    static constexpr bool PERM = true;
    bf16_t* XR; const float* modv;
    __device__ __forceinline__ void operator()(const f32x4 (&acc)[2][2][4][2], const Unit& u, int wr, int wc, int fr, int fq) const {
        const int row0 = u.pm * BM + wr * 64 + fr, col0 = u.pn * BM + wc * 32 + 8 * fq;
        const int tp = u.pm % PPB, v = tp == 0 ? 4 : u.pm / PPB; const float* gp = modv + (size_t)v * 6 * D + col0;
        f32x4 gv[2][2];
#pragma unroll
        for (int bj = 0; bj < 2; ++bj)
#pragma unroll
            for (int n = 0; n < 2; ++n) gv[bj][n] = *(const f32x4*)(gp + bj * HALF + n * 4);
#pragma unroll
        for (int ai = 0; ai < 2; ++ai)
#pragma unroll
            for (int m = 0; m < 4; ++m) { bf16_t* rowp = XR + (size_t)(row0 + ai * HALF + m * 16) * D + col0;
#pragma unroll
                for (int bj = 0; bj < 2; ++bj) { u32x4* p = (u32x4*)(rowp + bj * HALF); const u32x4 w = *p;
                    const f32x4 v0 = bf4((u32x2){w.x, w.y}) + gv[bj][0] * acc[ai][bj][m][0], v1 = bf4((u32x2){w.z, w.w}) + gv[bj][1] * acc[ai][bj][m][1];
                    *p = pack8(v0, v1); } }
    }
};
struct EpiSwiglu {
    static constexpr bool PERM = true;
    bf16_t* HH; int ldc; int prow_off;
    __device__ __forceinline__ void operator()(const f32x4 (&acc)[2][2][4][2], const Unit& u, int wr, int wc, int fr, int fq) const {
        const int row0 = (u.pm - prow_off) * BM + wr * 64 + fr, col0 = u.pn * HALF + wc * 32 + 8 * fq;
#pragma unroll
        for (int ai = 0; ai < 2; ++ai)
#pragma unroll
            for (int m = 0; m < 4; ++m) { f32x4 o[2];
#pragma unroll
                for (int n = 0; n < 2; ++n)
#pragma unroll
                    for (int q = 0; q < 4; ++q) { const float a1 = acc[ai][0][m][n][q], a3 = acc[ai][1][m][n][q]; o[n][q] = a1 * fast_sigmoid(a1) * a3; }
                *(u32x4*)(HH + (size_t)(row0 + ai * HALF + m * 16) * ldc + col0) = pack8(o[0], o[1]); }
    }
};
}

namespace att {
constexpr int NW = 8, QBLK = 32, KVBLK = 64;
__device__ __forceinline__ int crow(int r, int hi) { return (r & 3) + 8 * (r >> 2) + 4 * hi; }
#define SBAR() __builtin_amdgcn_sched_barrier(0)
template <int DK> struct Cfg { static constexpr int KSTR = DK * 2 + 16, KB = KVBLK * KSTR, VB = KVBLK * 64 * 2, NQ = DK / 16, NKL = DK / 64 + (DK % 64 ? 1 : 0);
    static constexpr int OFF_V = 0, OFF_K = 2 * VB, OFF_WS = 2 * VB + 2 * KB, BYTES = OFF_WS + NW * 64 * 4; };

__device__ __forceinline__ void partialSM(f32x16& p0, f32x16& p1, float& m_reg, float& alpha, float C, float thr_raw) {
    float pmax = p0[0];
#pragma unroll
    for (int r = 1; r < 16; ++r) pmax = fmaxf(pmax, p0[r]);
#pragma unroll
    for (int r = 0; r < 16; ++r) pmax = fmaxf(pmax, p1[r]);
    { auto rr = __builtin_amdgcn_permlane32_swap(__float_as_uint(pmax), __float_as_uint(pmax), false, false);
      pmax = fmaxf(__uint_as_float(rr[0]), __uint_as_float(rr[1])); }
    float mn;
    if (__builtin_expect(__all(pmax - m_reg <= thr_raw), 1)) { mn = m_reg; alpha = 1.f; }
    else { mn = fmaxf(m_reg, pmax); alpha = __builtin_amdgcn_exp2f((m_reg - mn) * C); m_reg = mn; }
    const float mnC = -mn * C;
#pragma unroll
    for (int r = 0; r < 16; ++r) p0[r] = fmaf(p0[r], C, mnC);
#pragma unroll
    for (int r = 0; r < 16; ++r) p1[r] = fmaf(p1[r], C, mnC);
#pragma unroll
    for (int r = 0; r < 16; ++r) p0[r] = __builtin_amdgcn_exp2f(p0[r]);
}
__device__ __forceinline__ void finishSM(f32x16& p0, f32x16& p1, float alpha, float& l_reg, bf16x8& pa0, bf16x8& pa1, bf16x8& pa2, bf16x8& pa3) {
#pragma unroll
    for (int r = 0; r < 16; ++r) p1[r] = __builtin_amdgcn_exp2f(p1[r]);
    float ps = 0;
#pragma unroll
    for (int r = 0; r < 16; ++r) ps += p0[r];
#pragma unroll
    for (int r = 0; r < 16; ++r) ps += p1[r];
    { auto rr = __builtin_amdgcn_permlane32_swap(__float_as_uint(ps), __float_as_uint(ps), false, false);
      ps = __uint_as_float(rr[0]) + __uint_as_float(rr[1]); }
    l_reg = l_reg * alpha + ps;
#define PK4(P, BASE, OUT) do { unsigned a0 = cvt_pk_bf16(P[BASE + 0], P[BASE + 1]), a1 = cvt_pk_bf16(P[BASE + 2], P[BASE + 3]);   \
    unsigned b0 = cvt_pk_bf16(P[BASE + 4], P[BASE + 5]), b1 = cvt_pk_bf16(P[BASE + 6], P[BASE + 7]);                              \
    auto r0 = __builtin_amdgcn_permlane32_swap(a0, b0, false, false); auto r1 = __builtin_amdgcn_permlane32_swap(a1, b1, false, false); \
    u32x4 w = {r0[0], r1[0], r0[1], r1[1]}; OUT = __builtin_bit_cast(bf16x8, w); } while (0)
    PK4(p0, 0, pa0); PK4(p0, 8, pa1); PK4(p1, 0, pa2); PK4(p1, 8, pa3);
#undef PK4
}
template <int DK> __device__ __forceinline__ void qkt(f32x16& p0, f32x16& p1, const LAS char* Ks, const bf16x8* qr, int r32, int hi) {
    p0 = f32x16{}; p1 = f32x16{};
    const LAS char* k0 = Ks + r32 * Cfg<DK>::KSTR + hi * 16;
#pragma unroll
    for (int d0 = 0; d0 < Cfg<DK>::NQ; ++d0) {
        const bf16x8 b0 = *(const LAS bf16x8*)(k0 + d0 * 32);
        const bf16x8 b1 = *(const LAS bf16x8*)(k0 + 32 * Cfg<DK>::KSTR + d0 * 32);
        p0 = __builtin_amdgcn_mfma_f32_32x32x16_bf16(b0, qr[d0], p0, 0, 0, 0);
        p1 = __builtin_amdgcn_mfma_f32_32x32x16_bf16(b1, qr[d0], p1, 0, 0, 0); }
}
__device__ __forceinline__ int v_st(int k, int c) { const int kk = (k & ~0xC) | ((k & 4) << 1) | ((k & 8) >> 1); return ((kk >> 3) * 2 + (c >> 5)) * 512 + ((kk & 7) * 32 + (c & 31)) * 2; }
__device__ __forceinline__ int v_rd_base(int lane) { return ((lane & 3) << 3) | (((lane >> 2) & 3) << 6) | (((lane >> 4) & 1) << 5) | (((lane >> 5) & 1) << 8); }
constexpr int v_rd_off(int d0, int ks, int half) { return d0 * 512 + ks * 2048 + half * 1024; }
template <int OFF> __device__ __forceinline__ s16x4 tr_read(int vb) {
    s16x4 r; asm volatile("ds_read_b64_tr_b16 %0, %1 offset:%2" : "=&v"(r) : "v"(vb), "i"(OFF) : "memory"); return r;
}
template <int D0> __device__ __forceinline__ void pv_one(f32x16& od, int vb, bf16x8 pa0, bf16x8 pa1, bf16x8 pa2, bf16x8 pa3) {
    const s16x4 l0 = tr_read<v_rd_off(D0, 0, 0)>(vb), h0 = tr_read<v_rd_off(D0, 0, 1)>(vb), l1 = tr_read<v_rd_off(D0, 1, 0)>(vb), h1 = tr_read<v_rd_off(D0, 1, 1)>(vb);
    const s16x4 l2 = tr_read<v_rd_off(D0, 2, 0)>(vb), h2 = tr_read<v_rd_off(D0, 2, 1)>(vb), l3 = tr_read<v_rd_off(D0, 3, 0)>(vb), h3 = tr_read<v_rd_off(D0, 3, 1)>(vb);
    asm volatile("s_waitcnt lgkmcnt(0)" ::: "memory"); SBAR();
#define PK(L, H) (bf16x8){L[0], L[1], L[2], L[3], H[0], H[1], H[2], H[3]}
    od = __builtin_amdgcn_mfma_f32_32x32x16_bf16(pa0, PK(l0, h0), od, 0, 0, 0);
    od = __builtin_amdgcn_mfma_f32_32x32x16_bf16(pa1, PK(l1, h1), od, 0, 0, 0);
    od = __builtin_amdgcn_mfma_f32_32x32x16_bf16(pa2, PK(l2, h2), od, 0, 0, 0);
    od = __builtin_amdgcn_mfma_f32_32x32x16_bf16(pa3, PK(l3, h3), od, 0, 0, 0);
#undef PK
}
__device__ __forceinline__ void pv_all(f32x16* o, int vb, bf16x8 pa0, bf16x8 pa1, bf16x8 pa2, bf16x8 pa3) {
    pv_one<0>(o[0], vb, pa0, pa1, pa2, pa3); pv_one<1>(o[1], vb, pa0, pa1, pa2, pa3);
}

template <int DK>
__device__ __forceinline__ void attn_unit(const bf16_t* __restrict__ Qb, int ldq, const bf16_t* __restrict__ Kh, int ldk, const bf16_t* __restrict__ Vh, int ldv,
                                          bf16_t* __restrict__ Ob, int ldo, int NT, float C, float thr_raw, LAS char* lds, const int tid) {
    using CF = Cfg<DK>;
    const int wid = tid >> 6, lane = tid & 63, r32 = lane & 31, hi = lane >> 5;
    LAS char* V_lds = lds + CF::OFF_V; LAS char* K_lds = lds + CF::OFF_K;
    LAS float* ws = (LAS float*)(lds + CF::OFF_WS) + wid * 64; LAS float* li_l = ws; LAS float* al_l = ws + 32;
    float m_reg = -1e30f, l_reg = 0; f32x16 o[2] = {}; bf16x8 qr[CF::NQ];
    const bf16_t* Qw = Qb + (size_t)(wid * QBLK + r32) * ldq + hi * 8;
#pragma unroll
    for (int d0 = 0; d0 < CF::NQ; ++d0) qr[d0] = *(const bf16x8*)(Qw + d0 * 16);
    constexpr int CPR = DK / 8;
    const int vrow = tid >> 3, vcol = (tid & 7) * 8, vst = v_st(vrow, vcol);
    const int kid0 = tid, kid1 = 512 + (tid & 255);
    const int kr0 = kid0 / CPR, kc0 = kid0 % CPR, kr1 = kid1 / CPR, kc1 = kid1 % CPR;
    const int kst0 = kr0 * CF::KSTR + kc0 * 16, kst1 = kr1 * CF::KSTR + kc1 * 16;
    const int vb0 = (int)(uintptr_t)V_lds + v_rd_base(lane);
    bf16x8 sv[2], sk0[2], sk1[2];
#define SLOAD(i, k0) do { sv[i] = *(const bf16x8*)(Vh + (size_t)((k0) + vrow) * ldv + vcol); \
    sk0[i] = *(const bf16x8*)(Kh + (size_t)((k0) + kr0) * ldk + kc0 * 8); \
    if (DK == 96) sk1[i] = *(const bf16x8*)(Kh + (size_t)((k0) + kr1) * ldk + kc1 * 8); } while (0)
#define SWRITE(b, i) do { *(LAS bf16x8*)(V_lds + (b) * CF::VB + vst) = sv[i]; *(LAS bf16x8*)(K_lds + (b) * CF::KB + kst0) = sk0[i]; \
    if (DK == 96) *(LAS bf16x8*)(K_lds + (b) * CF::KB + kst1) = sk1[i]; } while (0)
#define SWAIT() do { if (DK == 96) asm volatile("s_waitcnt vmcnt(3)" ::: "memory"); else asm volatile("s_waitcnt vmcnt(2)" ::: "memory"); } while (0)
#define RESC(a) do { if (__any((a) < 1.f)) { if (hi == 0) al_l[r32] = (a); asm volatile("s_waitcnt lgkmcnt(0)" ::: "memory"); \
    _Pragma("unroll") for (int d = 0; d < 2; ++d) _Pragma("unroll") for (int r = 0; r < 16; ++r) o[d][r] *= al_l[crow(r, hi)]; } } while (0)
    f32x16 pA0, pA1, pB0, pB1; float alA, alB; bf16x8 pa0, pa1, pa2, pa3;
    __syncthreads();
    SLOAD(0, 0); asm volatile("s_waitcnt vmcnt(0)" ::: "memory"); SWRITE(0, 0); __syncthreads();
    qkt<DK>(pA0, pA1, K_lds, qr, r32, hi); partialSM(pA0, pA1, m_reg, alA, C, thr_raw);
    SLOAD(1, KVBLK); if (2 < NT) SLOAD(0, 2 * KVBLK);
    SWAIT(); SWRITE(1, 1); __syncthreads();
    for (int j = 1; j + 1 < NT; j += 2) {
        SBAR(); qkt<DK>(pB0, pB1, K_lds + CF::KB, qr, r32, hi);
        finishSM(pA0, pA1, alA, l_reg, pa0, pa1, pa2, pa3); SBAR();
        SLOAD(1, (j + 2) * KVBLK); SBAR();
        pv_all(o, vb0, pa0, pa1, pa2, pa3); partialSM(pB0, pB1, m_reg, alB, C, thr_raw);
        __syncthreads(); SWAIT(); SWRITE(0, 0);
        RESC(alB); __syncthreads();
        SBAR(); qkt<DK>(pA0, pA1, K_lds, qr, r32, hi);
        finishSM(pB0, pB1, alB, l_reg, pa0, pa1, pa2, pa3); SBAR();
        if (j + 3 < NT) SLOAD(0, (j + 3) * KVBLK); SBAR();
        pv_all(o, vb0 + CF::VB, pa0, pa1, pa2, pa3); partialSM(pA0, pA1, m_reg, alA, C, thr_raw);
        __syncthreads(); SWAIT(); SWRITE(1, 1);
        RESC(alA); __syncthreads();
    }
    SBAR(); qkt<DK>(pB0, pB1, K_lds + CF::KB, qr, r32, hi);
    finishSM(pA0, pA1, alA, l_reg, pa0, pa1, pa2, pa3); SBAR();
    pv_all(o, vb0, pa0, pa1, pa2, pa3); partialSM(pB0, pB1, m_reg, alB, C, thr_raw);
    __syncthreads(); RESC(alB);
    finishSM(pB0, pB1, alB, l_reg, pa0, pa1, pa2, pa3); SBAR();
    pv_all(o, vb0 + CF::VB, pa0, pa1, pa2, pa3);
    if (hi == 0) li_l[r32] = l_reg; asm volatile("s_waitcnt lgkmcnt(0)" ::: "memory");
    float rli[16];
#pragma unroll
    for (int r = 0; r < 16; ++r) rli[r] = __builtin_amdgcn_rcpf(li_l[crow(r, hi)]);
    bf16_t* Ow = Ob + (size_t)(wid * QBLK) * ldo;
#pragma unroll
    for (int r = 0; r < 16; ++r) { const int orow = crow(r, hi);
#pragma unroll
        for (int d0 = 0; d0 < 2; ++d0) Ow[(size_t)orow * ldo + d0 * 32 + r32] = (bf16_t)(cvt_pk_bf16(o[d0][r] * rli[r], 0.f) & 0xffffu); }
#undef SLOAD
#undef SWRITE
#undef SWAIT
#undef RESC
}
#undef SBAR
}


namespace att2 {
constexpr int NW = 8, QBLK = 32, KVBLK = 64, NSLOT = 3, VSLOTB = 8192;
template <int DK> struct LL { static constexpr int NQ = DK / 16, KSLOTB = DK * 128, LDS_K = 0, LDS_V = NSLOT * KSLOTB, LDS_WS = LDS_V + NSLOT * VSLOTB, LDS_OST = LDS_WS + NW * 64 * 4, BYTES = LDS_OST + NW * 4096; };
__device__ __forceinline__ int crow(int r, int hi) { return (r & 3) + 8 * (r >> 2) + 4 * hi; }
#define SBAR() __builtin_amdgcn_sched_barrier(0)
__device__ __forceinline__ void glds16(const void* gsrc, unsigned lds_dst) { unsigned keep;
    asm volatile("s_mov_b32 %0, m0\n\ts_mov_b32 m0, %2\n\ts_nop 0\n\tglobal_load_lds_dwordx4 %1, off\n\ts_mov_b32 m0, %0" : "=&s"(keep) : "v"(gsrc), "s"(lds_dst) : "memory"); }
typedef __bf16 bf16x2_t __attribute__((ext_vector_type(2)));
__device__ __forceinline__ unsigned cvtpk_s(float lo, float hi) { f32x2 v = {lo, hi}; bf16x2_t b = __builtin_convertvector(v, bf16x2_t); return __builtin_bit_cast(unsigned, b); }
#define WAIT_BAR(N) asm volatile("s_waitcnt vmcnt(" #N ") lgkmcnt(0)\n\ts_barrier" ::: "memory")
typedef LAS const char* lds_cptr;
typedef short v4i16_t __attribute__((ext_vector_type(4)));
__device__ __forceinline__ void kload2(bf16x8* kf, lds_cptr kp, int j) { kf[2 * j] = *(const LAS bf16x8*)(kp + j * 2048); kf[2 * j + 1] = *(const LAS bf16x8*)(kp + j * 2048 + 512); }
__device__ __forceinline__ s16x4 vtr(lds_cptr p) { return __builtin_bit_cast(s16x4, __builtin_amdgcn_ds_read_tr16_b64_v4i16((LAS v4i16_t*)p)); }

template <int DK>
__device__ __forceinline__ bool attn_unit(const bf16_t* Qb, int ldq, const bf16_t* __restrict__ Kh, int ldk, const bf16_t* __restrict__ Vh, int ldv, bf16_t* Ob, int ldo, int NT, LAS char* shm, int tid) {
    using L = LL<DK>; constexpr int NQ = L::NQ, KSLOTB = L::KSLOTB;
    const int lane = tid & 63, r32 = lane & 31, hi = lane >> 5; const int wid = __builtin_amdgcn_readfirstlane(tid >> 6);
    const bf16_t* Qw = Qb + (long)(wid * QBLK) * ldq;
    const unsigned lds0 = (unsigned)(uintptr_t)shm;
    LAS float* wsf = (LAS float*)(shm + L::LDS_WS) + wid * 64;
    const bf16_t* ksrc = Kh + (long)lane * ldk + wid * 8;
    const bf16_t* ksrc2 = Kh + (long)((wid & 1) * 32 + r32) * ldk + 64 + (wid >> 1) * 8;
    const bf16_t* vsrc = Vh + (long)(16 * (wid & 3) + (lane >> 2)) * ldv + (wid >> 2) * 32 + (lane & 3) * 8;
    const unsigned kdst = lds0 + L::LDS_K + wid * 1024, kdst2 = lds0 + L::LDS_K + (8 + (wid >> 1)) * 1024 + (wid & 1) * 512, vdst = lds0 + L::LDS_V + wid * 1024;
#define DMA_K(t, ks) do { glds16(ksrc + (long)(t) * KVBLK * ldk, (unsigned)__builtin_amdgcn_readfirstlane(kdst + (ks))); \
        if (DK == 96) { if (hi == 0) glds16(ksrc2 + (long)(t) * KVBLK * ldk, (unsigned)__builtin_amdgcn_readfirstlane(kdst2 + (ks))); } } while (0)
#define DMA_V(t, vs) glds16(vsrc + (long)(t) * KVBLK * ldv, (unsigned)__builtin_amdgcn_readfirstlane(vdst + (vs)))
#define WAIT_NV() do { if (DK == 96) WAIT_BAR(3); else WAIT_BAR(2); } while (0)
    const lds_cptr shm3 = (lds_cptr)shm; const lds_cptr kp0 = shm3 + L::LDS_K + hi * 1024 + r32 * 16;
    const lds_cptr vp0 = shm3 + L::LDS_V + ((lane >> 4) & 1) * 32 + (lane & 3) * 8 + (4 * hi + ((lane & 15) >> 2)) * 64;
    bf16x8 kf[2 * NQ];
    DMA_K(0, 0); DMA_V(0, 0); DMA_K(1, KSLOTB);
    bf16x8 qr[NQ];
#pragma unroll
    for (int d0 = 0; d0 < NQ; ++d0) qr[d0] = *(const bf16x8*)(Qw + (long)r32 * ldq + d0 * 16 + hi * 8);
    float l_reg = 0.f; f32x16 o[2]; o[0] = f32x16{}; o[1] = f32x16{};
    f32x16 pA0, pA1, pB0, pB1;
    int ks_prev = 0, ks_cur = 0, ks_next = KSLOTB, vs_prev = 0, vs_cur = 0, vs_next = VSLOTB;
#define ROT() do { ks_prev = ks_cur; ks_cur = ks_next; ks_next = (ks_next == (NSLOT - 1) * KSLOTB) ? 0 : ks_next + KSLOTB; \
                   vs_prev = vs_cur; vs_cur = vs_next; vs_next = (vs_next == (NSLOT - 1) * VSLOTB) ? 0 : vs_next + VSLOTB; } while (0)
    DMA_K(2, 2 * KSLOTB);
    if (DK == 96) WAIT_BAR(5); else WAIT_BAR(3);
    { pA0 = f32x16{}; pA1 = f32x16{};
#pragma unroll
      for (int d0 = 0; d0 < NQ; ++d0) { const bf16x8 b0 = *(const LAS bf16x8*)(kp0 + d0 * 2048), b1 = *(const LAS bf16x8*)(kp0 + d0 * 2048 + 512);
          pA0 = __builtin_amdgcn_mfma_f32_32x32x16_bf16(b0, qr[d0], pA0, 0, 0, 0); pA1 = __builtin_amdgcn_mfma_f32_32x32x16_bf16(b1, qr[d0], pA1, 0, 0, 0); }
#pragma unroll
      for (int r = 0; r < 16; ++r) pA0[r] = __builtin_amdgcn_exp2f(pA0[r]);
#pragma unroll
      for (int r = 0; r < 16; ++r) pA1[r] = __builtin_amdgcn_exp2f(pA1[r]); }
    WAIT_BAR(0);
    DMA_K(3, 0); DMA_V(1, VSLOTB);
    ROT();
#pragma unroll
    for (int j = 0; j < NQ; ++j) kload2(kf, kp0 + ks_cur, j);
    WAIT_NV();
    s16x4 vlo[8], vhi[8]; u32x4 pw0, pw1, pw2, pw3;
#define PKW(P, B) cvtpk_s(P[B], P[B + 1])
#define PAF(k) __builtin_bit_cast(bf16x8, pw##k)
#define VFR(i) (bf16x8){vlo[i][0], vlo[i][1], vlo[i][2], vlo[i][3], vhi[i][0], vhi[i][1], vhi[i][2], vhi[i][3]}
#define PIN(x) asm volatile("" : "+v"(x))
#define GAPA(MF, A0, A1, A2, A3, W0, W1, PW) do { MF; sacc += A0; sacc += A1; sacc += A2; sacc += A3; PIN(sacc); W0; W1; PIN(PW); SBAR(); } while (0)
#define EX(v) __builtin_amdgcn_exp2f(v)
#define GAPB(MF, X, B) do { MF; X[B] = EX(X[B]); X[B + 1] = EX(X[B + 1]); X[B + 2] = EX(X[B + 2]); X[B + 3] = EX(X[B + 3]); PIN(X); SBAR(); } while (0)
#define VRD(i) do { vlo[i] = vtr(vp_ + (((i) >> 2) * 4096 + ((i) & 3) * 1024)); vhi[i] = vtr(vp_ + (((i) >> 2) * 4096 + ((i) & 3) * 1024 + 512)); } while (0)
#define KRD(G, j) do { if (G) { kload2(kf, kp0 + ks_next, j); SBAR(); } } while (0)
#define MF32 __builtin_amdgcn_mfma_f32_32x32x16_bf16
    const f32x16 Z16 = f32x16{};
#define STEP(C0, C1, P0, P1, t, GK, GV, GL) do { SBAR(); \
    const lds_cptr vp_ = vp0 + vs_prev; \
    VRD(0); SBAR(); float sacc = (P0[0] + P0[1]); \
    GAPA(C0 = MF32(kf[0], qr[0], Z16, 0, 0, 0), P0[2], P0[3], P0[4], P0[5],     pw0[0] = PKW(P0, 0), pw0[1] = PKW(P0, 2), pw0); \
    VRD(4); SBAR(); GAPA(C1 = MF32(kf[1], qr[0], Z16, 0, 0, 0), P0[6], P0[7], P0[8], P0[9],     pw0[2] = PKW(P0, 4), pw0[3] = PKW(P0, 6), pw0); \
    VRD(1); SBAR(); GAPA(C0 = MF32(kf[2], qr[1], C0, 0, 0, 0),   P0[10], P0[11], P0[12], P0[13], pw1[0] = PKW(P0, 8), pw1[1] = PKW(P0, 10), pw1); \
    VRD(5); SBAR(); GAPA(C1 = MF32(kf[3], qr[1], C1, 0, 0, 0),   P0[14], P0[15], P1[0], P1[1],   pw1[2] = PKW(P0, 12), pw1[3] = PKW(P0, 14), pw1); \
    VRD(2); SBAR(); GAPA(C0 = MF32(kf[4], qr[2], C0, 0, 0, 0),   P1[2], P1[3], P1[4], P1[5],     pw2[0] = PKW(P1, 0), pw2[1] = PKW(P1, 2), pw2); \
    VRD(6); SBAR(); GAPA(C1 = MF32(kf[5], qr[2], C1, 0, 0, 0),   P1[6], P1[7], P1[8], P1[9],     pw2[2] = PKW(P1, 4), pw2[3] = PKW(P1, 6), pw2); \
    VRD(3); SBAR(); GAPA(C0 = MF32(kf[6], qr[3], C0, 0, 0, 0),   P1[10], P1[11], P1[12], P1[13], pw3[0] = PKW(P1, 8), pw3[1] = PKW(P1, 10), pw3); \
    VRD(7); SBAR(); GAPA(C1 = MF32(kf[7], qr[3], C1, 0, 0, 0),   P1[14], P1[15], 0.f, 0.f,       pw3[2] = PKW(P1, 12), pw3[3] = PKW(P1, 14), pw3); \
    if constexpr (DK == 96) { C0 = MF32(kf[8], qr[4], C0, 0, 0, 0); C1 = MF32(kf[9], qr[4], C1, 0, 0, 0); C0 = MF32(kf[10], qr[5], C0, 0, 0, 0); C1 = MF32(kf[11], qr[5], C1, 0, 0, 0); SBAR(); } \
    l_reg += sacc; \
    if (GK) { DMA_K((t) + 3, ks_cur); } if (GV) { DMA_V((t) + 1, vs_next); } \
    SBAR(); \
    GAPB(o[0] = MF32(PAF(0), VFR(0), o[0], 0, 0, 0), C0, 0); \
    GAPB(o[1] = MF32(PAF(0), VFR(4), o[1], 0, 0, 0), C0, 4); \
    KRD(GL, 0); GAPB(o[0] = MF32(PAF(1), VFR(1), o[0], 0, 0, 0), C0, 8); \
    KRD(GL, 1); GAPB(o[1] = MF32(PAF(1), VFR(5), o[1], 0, 0, 0), C0, 12); \
    KRD(GL, 2); GAPB(o[0] = MF32(PAF(2), VFR(2), o[0], 0, 0, 0), C1, 0); \
    KRD(GL, 3); GAPB(o[1] = MF32(PAF(2), VFR(6), o[1], 0, 0, 0), C1, 4); \
    if constexpr (DK == 96) { KRD(GL, 4); } GAPB(o[0] = MF32(PAF(3), VFR(3), o[0], 0, 0, 0), C1, 8); \
    if constexpr (DK == 96) { KRD(GL, 5); } GAPB(o[1] = MF32(PAF(3), VFR(7), o[1], 0, 0, 0), C1, 12); \
    } while (0)
    int t = 1;
    for (; t + 5 < NT; t += 2) {
        STEP(pB0, pB1, pA0, pA1, t, true, true, true);     WAIT_NV(); ROT();
        STEP(pA0, pA1, pB0, pB1, t + 1, true, true, true); WAIT_NV(); ROT();
    }
#define ENDW(tt) do { if ((tt) + 3 < NT) { WAIT_NV(); } else if ((tt) + 2 < NT) { WAIT_BAR(1); } else { WAIT_BAR(0); } } while (0)
    for (; t + 1 < NT; t += 2) {
        STEP(pB0, pB1, pA0, pA1, t, (t + 3 < NT), (t + 1 < NT), (t + 1 < NT));       ENDW(t);     ROT();
        STEP(pA0, pA1, pB0, pB1, t + 1, (t + 4 < NT), (t + 2 < NT), (t + 2 < NT));   ENDW(t + 1); ROT();
    }
    STEP(pB0, pB1, pA0, pA1, NT - 1, false, false, false);
    { float sacc = pB0[0] + pB0[1];
#pragma unroll
      for (int r = 2; r < 16; ++r) sacc += pB0[r];
#pragma unroll
      for (int r = 0; r < 16; ++r) sacc += pB1[r];
      l_reg += sacc;
      pw0 = (u32x4){PKW(pB0, 0), PKW(pB0, 2), PKW(pB0, 4), PKW(pB0, 6)}; pw1 = (u32x4){PKW(pB0, 8), PKW(pB0, 10), PKW(pB0, 12), PKW(pB0, 14)};
      pw2 = (u32x4){PKW(pB1, 0), PKW(pB1, 2), PKW(pB1, 4), PKW(pB1, 6)}; pw3 = (u32x4){PKW(pB1, 8), PKW(pB1, 10), PKW(pB1, 12), PKW(pB1, 14)};
      SBAR();
      const lds_cptr vp_ = vp0 + vs_cur;
#pragma unroll
      for (int i = 0; i < 8; ++i) VRD(i);
      o[0] = MF32(PAF(0), VFR(0), o[0], 0, 0, 0); o[0] = MF32(PAF(1), VFR(1), o[0], 0, 0, 0); o[0] = MF32(PAF(2), VFR(2), o[0], 0, 0, 0); o[0] = MF32(PAF(3), VFR(3), o[0], 0, 0, 0);
      o[1] = MF32(PAF(0), VFR(4), o[1], 0, 0, 0); o[1] = MF32(PAF(1), VFR(5), o[1], 0, 0, 0); o[1] = MF32(PAF(2), VFR(6), o[1], 0, 0, 0); o[1] = MF32(PAF(3), VFR(7), o[1], 0, 0, 0); }
    { auto rr = __builtin_amdgcn_permlane32_swap(__float_as_uint(l_reg), __float_as_uint(l_reg), false, false); l_reg = __uint_as_float(rr[0]) + __uint_as_float(rr[1]); }
    const bool bad = __any(!(l_reg > 1e-30f && l_reg < 1e30f));
    if (hi == 0) wsf[32 + r32] = l_reg; asm volatile("s_waitcnt lgkmcnt(0)" ::: "memory");
    float rli[16];
#pragma unroll
    for (int r = 0; r < 16; ++r) rli[r] = __builtin_amdgcn_rcpf(wsf[32 + crow(r, hi)]);
    bf16_t* Ow = Ob + (long)(wid * QBLK) * ldo;
    { LAS bf16_t* stg = (LAS bf16_t*)(shm + L::LDS_OST) + wid * 2048;
#pragma unroll
      for (int r = 0; r < 16; ++r) { const int orow = crow(r, hi);
#pragma unroll
          for (int d0 = 0; d0 < 2; ++d0) stg[orow * 64 + d0 * 32 + r32] = (bf16_t)(cvtpk_s(o[d0][r] * rli[r], 0.f) & 0xffffu); }
      asm volatile("s_waitcnt lgkmcnt(0)" ::: "memory");
#pragma unroll
      for (int i = 0; i < 4; ++i) { const int row = i * 8 + (lane >> 3), ch = lane & 7; const u32x4 v = *(const LAS u32x4*)(stg + row * 64 + ch * 8); *(u32x4*)(Ow + (long)row * ldo + ch * 8) = v; } }
    return bad;
#undef DMA_K
#undef DMA_V
#undef WAIT_NV
#undef ROT
#undef PKW
#undef PAF
#undef VFR
#undef PIN
#undef GAPA
#undef EX
#undef GAPB
#undef VRD
#undef KRD
#undef MF32
#undef STEP
#undef ENDW
}
#undef SBAR
#undef WAIT_BAR
}

#define XB_TMO      128
#define XB_XCNT(j)  (256  + 64 * (j))
#define XB_XSUB(j)  (1280 + 64 * (j))
#define XB_XGEN(j)  (2304 + 64 * (j))
#define XB_TOP      3328
#define XB_TOPGEN   3392
#define XCD_BAR_WORDS 3456
#define XB_SPIN_CAP (1u << 24)
__device__ __forceinline__ unsigned xb_ld(unsigned* p)              { return __hip_atomic_load(p, __ATOMIC_RELAXED, __HIP_MEMORY_SCOPE_AGENT); }
__device__ __forceinline__ unsigned xb_add(unsigned* p, unsigned v) { return __hip_atomic_fetch_add(p, v, __ATOMIC_RELAXED, __HIP_MEMORY_SCOPE_AGENT); }
__device__ __forceinline__ unsigned xb_xcc_id() { return (unsigned)__builtin_amdgcn_s_getreg((3 << 11) | 20) & 0xFu; }
#define XB_SPIN(cond, bar) do { unsigned _sp = 0; while (cond) { __builtin_amdgcn_s_sleep(1); \
    if ((++_sp & 255u) == 0u) { if (xb_ld(&(bar)[XB_TMO])) break; if (_sp > XB_SPIN_CAP) { atomicAdd(&(bar)[XB_TMO], 1u); break; } } } } while (0)
struct XcdBarrier { unsigned* bar; unsigned x; volatile LAS unsigned* st; };
__device__ __forceinline__ XcdBarrier xcd_barrier_post(unsigned* bar, volatile LAS unsigned* st) {
    XcdBarrier b; b.bar = bar; b.x = xb_xcc_id(); b.st = st;
    if (threadIdx.x == 0) (void)xb_add(&bar[XB_XCNT(b.x)], 1u);
    return b;
}
__device__ __forceinline__ void xcd_barrier_complete(unsigned* bar, unsigned x, unsigned& nloc, unsigned& nx) {
    const unsigned G = gridDim.x * gridDim.y * gridDim.z;
    unsigned sum, cnt, mine, sp = 0u;
    for (;;) {
        sum = 0u; cnt = 0u; mine = 0u;
#pragma unroll
        for (unsigned j = 0; j < 16; ++j) { const unsigned c = xb_ld(&bar[XB_XCNT(j)]); sum += c; cnt += (c > 0u) ? 1u : 0u; mine = (j == x) ? c : mine; }
        if (sum == G) break;
        __builtin_amdgcn_s_sleep(1);
        if ((++sp & 255u) == 0u) { if (xb_ld(&bar[XB_TMO])) break; if (sp > XB_SPIN_CAP) { atomicAdd(&bar[XB_TMO], 1u); break; } }
    }
    nloc = mine > 0u ? mine : 1u; nx = cnt > 0u ? cnt : 1u;
}
__device__ __forceinline__ void xcd_barrier(const XcdBarrier& b) {
    asm volatile("s_waitcnt vmcnt(0)" ::: "memory");
    __syncthreads();
    if (threadIdx.x == 0) {
        unsigned* bar = b.bar;
        __builtin_amdgcn_s_waitcnt(0);
        unsigned nloc = b.st[0], nx = b.st[1];
        if (nloc == 0u) { xcd_barrier_complete(bar, b.x, nloc, nx); b.st[0] = nloc; b.st[1] = nx; }
        const unsigned old = xb_add(&bar[XB_XSUB(b.x)], 1u);
        const unsigned gen = old / nloc;
        if (old + 1u == (gen + 1u) * nloc) {
            __builtin_amdgcn_fence(__ATOMIC_RELEASE, "agent");
            asm volatile("s_waitcnt vmcnt(0)" ::: "memory");
            const unsigned og = xb_add(&bar[XB_TOP], 1u);
            const unsigned tg = og / nx;
            if (og + 1u == (tg + 1u) * nx) xb_add(&bar[XB_TOPGEN], 1u);
            else XB_SPIN(xb_ld(&bar[XB_TOPGEN]) == tg, bar);
            __builtin_amdgcn_fence(__ATOMIC_ACQUIRE, "agent");
            xb_add(&bar[XB_XGEN(b.x)], 1u);
            asm volatile("s_waitcnt vmcnt(0)" ::: "memory");
        } else {
            XB_SPIN(xb_ld(&bar[XB_XGEN(b.x)]) == gen, bar);
            __builtin_amdgcn_fence(__ATOMIC_ACQUIRE, "agent");
            asm volatile("s_waitcnt vmcnt(0)" ::: "memory");
        }
    }
    __syncthreads();
}

struct Args {
    const float* in[26];
    float* out;
    unsigned char* ws;
    int ph_lo, ph_hi;
    float inv_mla[8];
    float inv_gqa[16];
};
enum { IN_X = 0, IN_C, IN_CTX, IN_CCTX, IN_WADA, IN_BADA, IN_N1G, IN_N2G, IN_WIN, IN_QNG, IN_WQB, IN_KVNG, IN_WKVB, IN_GQG, IN_GKG, IN_WOM, IN_WOG, IN_WOUT,
       IN_DW1, IN_DW3, IN_DW2, IN_ROUTER, IN_MW1, IN_MW3, IN_MW2, IN_FNG };

struct Ctx { int lane, wave, gw, NGW, vcu, G; LAS unsigned char* lds; };

__device__ __forceinline__ void cvt_item(const float* src, int ldw, bf16_t* dst, int K, int k0, LAS float* scr, int lane, const float* kg = nullptr) {
    if (src) {
#pragma unroll 8
        for (int i = 0; i < 32; ++i) { const int kk = 2 * i + (lane >> 5); const float gk = kg ? kg[k0 + kk] : 1.0f; scr[kk * 33 + (lane & 31)] = src[(size_t)(k0 + kk) * ldw + (lane & 31)] * gk; }
    }
    asm volatile("s_waitcnt vmcnt(0) lgkmcnt(0)" ::: "memory");
    const int c = lane & 7;
#pragma unroll
    for (int j = 0; j < 4; ++j) { const int n = (lane >> 3) + 8 * j; const LAS float* s = scr + (8 * c) * 33 + n;
        u32x4 o = (u32x4){0u, 0u, 0u, 0u};
        if (src) { o.x = cvt_pk_bf16(s[0 * 33], s[1 * 33]); o.y = cvt_pk_bf16(s[2 * 33], s[3 * 33]); o.z = cvt_pk_bf16(s[4 * 33], s[5 * 33]); o.w = cvt_pk_bf16(s[6 * 33], s[7 * 33]); }
        *(u32x4*)(dst + (size_t)n * K + k0 + 8 * c) = o; }
    asm volatile("s_waitcnt lgkmcnt(0)" ::: "memory");
}
template <int KIND>
__device__ __forceinline__ void cvt_job(const Ctx& X, int& base, int ngroups, int K, bf16_t* dst, const float* p0, const float* p1, int ldw, int gmax, const float* kg = nullptr, int ldd = 0) {
    const int nkb = K / 64, nitems = ngroups * nkb; if (ldd == 0) ldd = K;
    LAS float* scr = (LAS float*)(X.lds + X.wave * 8448);
    int first = X.gw - (base % X.NGW); if (first < 0) first += X.NGW;
    for (int it = first; it < nitems; it += X.NGW) {
        const int g = it / nkb, kb = it % nkb; const float* src;
        if (KIND == 0) { src = p0 + g * 32; if (g >= gmax) src = nullptr; }
        else if (KIND == 1) { const int pn = g >> 3, j = g & 7; const size_t off = (size_t)pn * 128 + (j & 3) * 32; const size_t d = (j >> 2) ? (size_t)(p1 - p0) : 0; src = p0 + d + off; }
        else if (KIND == 2) { src = g < 16 ? p0 + (g >> 1) * 96 + (g & 1) * 32 : p0 + (g - 16) * 96 + 64; }
        else {
            if (g < 21) src = p0 + g * 32;
            else if (g < 24) src = nullptr;
            else if (g < 40) { const int t = (g - 24) >> 3, j = (g - 24) & 7; src = p0 + 672 + (4 * t + (j & 3)) * 64 + 32 * (j >> 2); }
            else if (g < 48) { const int j = g - 40, wc = j & 3, bj = j >> 2; src = wc < 2 ? p0 + 1184 + wc * 64 + 32 * bj : p0 + 1312 + (wc - 2) * 64 + 32 * bj; }
            else src = p0 + 1440 + (g - 48) * 32; }
        cvt_item(src, ldw, dst + (size_t)g * 32 * ldd, ldd, kb * 64, scr, X.lane, kg);
    }
    base += nitems;
}
__device__ __forceinline__ void cvt_moe_layer(const Ctx& X, int& base, const float* mw1, const float* mw3, const float* mw2, unsigned char* ws, int li) {
    bf16_t* w13 = (bf16_t*)(ws + WS_WMOE13); bf16_t* w2 = (bf16_t*)(ws + WS_WMOE2);
    for (int e = 0; e < NE; ++e) {
        const float* w1 = mw1 + (size_t)(li * NE + e) * D * FE; const float* w3 = mw3 + (size_t)(li * NE + e) * D * FE;
        cvt_job<1>(X, base, 2 * FE / 32, D, w13 + (size_t)e * 2 * FE * D, w1, w3, FE, 1 << 30);
        const float* w2s = mw2 + (size_t)(li * NE + e) * FE * D;
        cvt_job<0>(X, base, D / 32, FE, w2 + (size_t)e * D * FE, w2s, w2s, D, 1 << 30);
    }
}
__device__ __forceinline__ void sincos_d(float ang, float& c, float& s) {
    const double a = (double)ang; const double k = __builtin_rint(a * 0.63661977236758134308); const long n = (long)k;
    const double r = (a - k * 1.57079632673412561417e+00) - k * 6.07710050650619224932e-11;
    const double r2 = r * r;
    double sp = -7.6471637318198164759e-13; sp = sp * r2 + 1.6059043836821614599e-10; sp = sp * r2 - 2.5052108385441718775e-08; sp = sp * r2 + 2.7557319223985890653e-06;
    sp = sp * r2 - 1.9841269841269841270e-04; sp = sp * r2 + 8.3333333333333333333e-03; sp = sp * r2 - 1.6666666666666666667e-01; const double sr = r + r * r2 * sp;
    double cp = 4.7794773323873852974e-14; cp = cp * r2 - 1.1470745597729724714e-11; cp = cp * r2 + 2.0876756987868098979e-09; cp = cp * r2 - 2.7557319223985890653e-07;
    cp = cp * r2 + 2.4801587301587301587e-05; cp = cp * r2 - 1.3888888888888888889e-03; cp = cp * r2 + 4.1666666666666666667e-02; const double cr = 1.0 - 0.5 * r2 + r2 * r2 * cp;
    const int q = (int)(n & 3);
    const double sv = (q == 0) ? sr : (q == 1) ? cr : (q == 2) ? -sr : -cr;
    const double cv = (q == 0) ? cr : (q == 1) ? -sr : (q == 2) ? -cr : sr;
    c = (float)cv; s = (float)sv;
}


__device__ __forceinline__ void lds_fill(LAS unsigned char* dst, const float* src, int n4, int tid) {
    for (int i = tid; i < n4; i += 512) ((LAS f32x4*)dst)[i] = ((const f32x4*)src)[i];
}
constexpr int TL_GAIN = 0, TL_MOD = 4096, TL_G2 = 4096 + 40960, TL_ROUTER = 65536, TL_ROPEM = 98304, TL_ROPEG = 106496;

template <bool FIRST, bool COMBINE>
__device__ __forceinline__ void norm1_rows(const Ctx& X, int l, bf16_t* XR, bf16_t* Hb, const bf16_t* Yg, const float* modp, const i32x2* tok_slot, const f32x2* tok_w,
                                           const float* gain, const float* xin, const float* cin, int tid) {
    const int lane = X.lane; const float* modl = modp + (size_t)l * 5 * 6 * D;
    lds_fill(X.lds + TL_GAIN, gain, D / 4, tid);
    for (int v = 0; v < 5; ++v) { lds_fill(X.lds + TL_MOD + v * 8192, modl + (size_t)v * 6 * D, 2 * D / 4, tid);
        if (COMBINE) lds_fill(X.lds + TL_G2 + v * 4096, modp + ((size_t)((l - 1) * 5 + v) * 6 + 5) * D, D / 4, tid); }
    __syncthreads();
    auto src_of = [&](int row) -> const float* { const int b = row / TPB, t = row - b * TPB;
        return t < NCTX ? cin + ((size_t)b * NCTX + t) * D : xin + ((size_t)b * SEQ + (t - NCTX)) * D; };
    f32x4 xnf[4]; u32x2 xnb[4]; i32x2 sln = (i32x2){0, 0}; f32x2 wn = (f32x2){0.f, 0.f};
    { const int row0 = X.gw < T ? X.gw : T - 1;
      if (FIRST) { const float* src = src_of(row0);
#pragma unroll
          for (int j = 0; j < 4; ++j) xnf[j] = ((const f32x4*)src)[lane + 64 * j]; }
      else {
#pragma unroll
          for (int j = 0; j < 4; ++j) xnb[j] = ((const u32x2*)(XR + (size_t)row0 * D))[lane + 64 * j]; }
      if (COMBINE) { sln = tok_slot[row0]; wn = tok_w[row0]; } }
    for (int row = X.gw; row < T; row += X.NGW) {
        const int b = row / TPB, t = row - b * TPB, v = t < NCTX ? 4 : b;
        f32x4 x[4]; const i32x2 sl = sln; const f32x2 w = wn;
#pragma unroll
        for (int j = 0; j < 4; ++j) x[j] = FIRST ? xnf[j] : bf4(xnb[j]);
        u32x2 ya[4], yb[4];
        if (COMBINE) {
#pragma unroll
            for (int j = 0; j < 4; ++j) { ya[j] = ((const u32x2*)(Yg + (size_t)sl.x * D))[lane + 64 * j]; yb[j] = ((const u32x2*)(Yg + (size_t)sl.y * D))[lane + 64 * j]; } }
        { const int nrow = row + X.NGW; if (nrow < T) {
            if (FIRST) { const float* src = src_of(nrow);
#pragma unroll
                for (int j = 0; j < 4; ++j) xnf[j] = ((const f32x4*)src)[lane + 64 * j]; }
            else {
#pragma unroll
                for (int j = 0; j < 4; ++j) xnb[j] = ((const u32x2*)(XR + (size_t)nrow * D))[lane + 64 * j]; }
            if (COMBINE) { sln = tok_slot[nrow]; wn = tok_w[nrow]; } } }
        if (COMBINE) { const LAS f32x4* g2 = (const LAS f32x4*)(X.lds + TL_G2 + v * 4096);
#pragma unroll
            for (int j = 0; j < 4; ++j) { const f32x4 g = g2[lane + 64 * j];
                x[j][0] += g[0] * (w.x * bflo(ya[j].x) + w.y * bflo(yb[j].x)); x[j][1] += g[1] * (w.x * bfhi(ya[j].x) + w.y * bfhi(yb[j].x));
                x[j][2] += g[2] * (w.x * bflo(ya[j].y) + w.y * bflo(yb[j].y)); x[j][3] += g[3] * (w.x * bfhi(ya[j].y) + w.y * bfhi(yb[j].y)); } }
        if (FIRST || COMBINE) {
#pragma unroll
            for (int j = 0; j < 4; ++j) { u32x2 o; o.x = cvt_pk_bf16(x[j][0], x[j][1]); o.y = cvt_pk_bf16(x[j][2], x[j][3]); ((u32x2*)(XR + (size_t)row * D))[lane + 64 * j] = o; } }
        float ss = 0.f;
#pragma unroll
        for (int j = 0; j < 4; ++j) ss += (x[j][0] * x[j][0] + x[j][1] * x[j][1]) + (x[j][2] * x[j][2] + x[j][3] * x[j][3]);
        const float rstd = 1.0f / sqrtf(wave_sum(ss) * (1.0f / D) + EPS);
        const LAS f32x4* gl = (const LAS f32x4*)(X.lds + TL_GAIN); const LAS f32x4* sh = (const LAS f32x4*)(X.lds + TL_MOD + v * 8192); const LAS f32x4* sc = sh + D / 4;
#pragma unroll
        for (int j = 0; j < 4; ++j) { const f32x4 g = gl[lane + 64 * j], s1 = sc[lane + 64 * j], s0 = sh[lane + 64 * j];
            const f32x4 h = (x[j] * rstd * g) * (s1 + 1.0f) + s0; u32x2 o; o.x = cvt_pk_bf16(h[0], h[1]); o.y = cvt_pk_bf16(h[2], h[3]);
            ((u32x2*)(Hb + (size_t)row * D))[lane + 64 * j] = o; }
    }
}

typedef const __attribute__((address_space(4))) Args CArgs;
__device__ __forceinline__ CArgs* get_args() { unsigned long long kp = (unsigned long long)__builtin_amdgcn_kernarg_segment_ptr(); asm volatile("" : "+s"(kp)); return (CArgs*)kp; }
__device__ __forceinline__ Ctx make_ctx(LAS unsigned char* lds, int tid, int bx, int G) {
    Ctx X; X.lds = lds; X.lane = tid & 63; X.wave = __builtin_amdgcn_readfirstlane(tid >> 6);
    X.G = G; X.vcu = (G % 8 == 0) ? (bx % 8) * (G / 8) + bx / 8 : bx;
    X.gw = X.vcu * 8 + X.wave; X.NGW = G * 8; return X;
}
#ifndef PH_MASK
#define PH_MASK 0xffffffffu
#endif
#define PH(n) (((PH_MASK) >> (n)) & 1u)

__global__ void __launch_bounds__(512, 2) mega_fwd(Args a_unused) {
    extern __shared__ __attribute__((aligned(16))) unsigned char lds_raw[];
    LAS unsigned char* const lds = (LAS unsigned char*)lds_raw;
    volatile LAS unsigned* const LC = (volatile LAS unsigned*)(lds + LDSCTL_OFF);
    for (int u = threadIdx.x; u < 128; u += 512) LC[u] = 0u;
    __syncthreads();
    int lo, hi;
    { CArgs* ap = get_args(); lo = ap->ph_lo; hi = ap->ph_hi;
      if (!MK_MULTI) { (void)xcd_barrier_post((unsigned*)(ap->ws + WS_CTL) + CW_BAR, LC); } }
    int step = 0;
#define STEP_ON(k) (step >= lo && step < hi && PH(k))
#define STEP_END do { if (step >= lo && step + 1 < hi) { CArgs* ap_ = get_args(); XcdBarrier b_; b_.bar = (unsigned*)(ap_->ws + WS_CTL) + CW_BAR; b_.x = xb_xcc_id(); b_.st = LC; xcd_barrier(b_); } ++step; } while (0)
#define PHASE_VARS CArgs* ap = get_args(); unsigned char* const ws = ap->ws; int tid = threadIdx.x; asm volatile("" : "+v"(tid)); int bx_ = blockIdx.x, G_ = gridDim.x; asm volatile("" : "+s"(bx_), "+s"(G_)); \
    const Ctx X = make_ctx(lds, tid, bx_, G_); const int lane = X.lane; (void)lane; (void)ws

    if (STEP_ON(0)) {
        PHASE_VARS;
        float* modp = (float*)(ws + WS_MOD); float* rope_m = (float*)(ws + WS_ROPE_MLA); float* rope_g = (float*)(ws + WS_ROPE_GQA);
        LAS float* sl = (LAS float*)(lds + 73728);
        { const float* cin = ap->in[IN_C]; const float* ccin = ap->in[IN_CCTX];
          for (int i = tid; i < 5 * D; i += 512) { const int v = i / D, k = i % D; const float c = v < 4 ? cin[v * D + k] : ccin[k]; sl[i] = c / (1.0f + __expf(-c)); } }
        __syncthreads();
        LAS float* part = (LAS float*)(lds + 73728 + 20480);
        { const float* wada = ap->in[IN_WADA]; const float* bada = ap->in[IN_BADA];
          for (int bi = X.vcu; bi < DEPTH * 96; bi += X.G) {
            const int l = bi / 96, cg = bi % 96, col = cg * 64 + lane;
            const float* wp = wada + (size_t)l * D * 6 * D + col;
            float s0 = 0.f, s1 = 0.f, s2 = 0.f, s3 = 0.f, s4 = 0.f;
#pragma unroll 8
            for (int kk = 0; kk < 128; ++kk) { const int k = X.wave * 128 + kk; const float w = wp[(size_t)k * 6 * D];
                s0 += sl[k] * w; s1 += sl[D + k] * w; s2 += sl[2 * D + k] * w; s3 += sl[3 * D + k] * w; s4 += sl[4 * D + k] * w; }
            part[(X.wave * 5 + 0) * 64 + lane] = s0; part[(X.wave * 5 + 1) * 64 + lane] = s1; part[(X.wave * 5 + 2) * 64 + lane] = s2;
            part[(X.wave * 5 + 3) * 64 + lane] = s3; part[(X.wave * 5 + 4) * 64 + lane] = s4;
            __syncthreads();
            if (tid < 320) { const int v = tid / 64, ln = tid % 64; float s = bada[l * 6 * D + cg * 64 + ln];
#pragma unroll
                for (int w = 0; w < 8; ++w) s += part[(w * 5 + v) * 64 + ln];
                modp[((size_t)(l * 5 + v) * 6) * D + cg * 64 + ln] = s; }
            __syncthreads();
          } }
        { const int gt = X.vcu * 512 + tid;
          if (gt < 128 * 8) { const int pos = gt >> 3, f = gt & 7; float c, s; sincos_d((float)pos * ap->inv_mla[f], c, s); rope_m[pos * 16 + f] = c; rope_m[pos * 16 + 8 + f] = s; }
          else if (gt < 128 * 8 + 128 * 16) { const int g2 = gt - 128 * 8, pos = g2 >> 4, f = g2 & 15; float c, s; sincos_d((float)pos * ap->inv_gqa[f], c, s); rope_g[pos * 32 + f] = c; rope_g[pos * 32 + 16 + f] = s; } }
        int base = 0;
        for (int l = 0; l < DEPTH; ++l) {
            unsigned char* wl = ws + WS_WSM + (size_t)l * LW;
            { const float* w = ap->in[IN_WIN] + (size_t)l * D * 3488; cvt_job<3>(X, base, DINP / 32, D, (bf16_t*)(wl + OFF_WIN), w, w, 3488, 1 << 30); }
            { const float* w = ap->in[IN_WQB] + (size_t)l * 384 * 768; cvt_job<2>(X, base, 24, 384, (bf16_t*)(wl + OFF_WQB), w, w, 768, 1 << 30, ap->in[IN_QNG] + l * 384); }
            { const float* w = ap->in[IN_WKVB] + (size_t)l * 256 * 1024; cvt_job<0>(X, base, 32, 256, (bf16_t*)(wl + OFF_WKVB), w, w, 1024, 1 << 30, ap->in[IN_KVNG] + l * 256, 384); }
            { const float* w = ap->in[IN_WOM] + (size_t)l * 512 * 1024; cvt_job<0>(X, base, 32, 512, (bf16_t*)(wl + OFF_WOM), w, w, 1024, 1 << 30); }
            { const float* w = ap->in[IN_WOG] + (size_t)l * 512 * 1024; cvt_job<0>(X, base, 32, 512, (bf16_t*)(wl + OFF_WOG), w, w, 1024, 1 << 30); }
            { const float* w = ap->in[IN_WOUT] + (size_t)l * 1024 * 1024; cvt_job<0>(X, base, 32, 1024, (bf16_t*)(wl + OFF_WOUT), w, w, 1024, 1 << 30); }
        }
        for (int li = 0; li < 2; ++li) {
            unsigned char* wd = ws + WS_WDEN + (size_t)li * LWD;
            const float* w1 = ap->in[IN_DW1] + (size_t)li * D * FD; const float* w3 = ap->in[IN_DW3] + (size_t)li * D * FD; const float* w2 = ap->in[IN_DW2] + (size_t)li * FD * D;
            cvt_job<1>(X, base, 2 * FD / 32, D, (bf16_t*)wd, w1, w3, FD, 1 << 30);
            cvt_job<0>(X, base, D / 32, FD, (bf16_t*)(wd + SZ_W13D), w2, w2, D, 1 << 30);
        }
        cvt_moe_layer(X, base, ap->in[IN_MW1], ap->in[IN_MW3], ap->in[IN_MW2], ws, 0);
    }
    STEP_END;

    for (int l = 0; l < DEPTH; ++l) {
        const bool moe = (l & 1) != 0, prev_moe = l > 0 && ((l - 1) & 1) != 0; const int last = (l == DEPTH - 1) ? 1 : 0;
        if (STEP_ON(1)) {
            PHASE_VARS;
            bf16_t* XR = (bf16_t*)(ws + WS_XR); bf16_t* Hb = (bf16_t*)(ws + WS_H); const bf16_t* Yg = (const bf16_t*)(ws + WS_YG);
            const float* modp = (const float*)(ws + WS_MOD); const float* modl = modp + (size_t)l * 5 * 6 * D;
            const i32x2* tok_slot = (const i32x2*)(ws + WS_TOK_SLOT); const f32x2* tok_w = (const f32x2*)(ws + WS_TOK_W);
            const float* gain = ap->in[IN_N1G] + l * D; const float* xin = ap->in[IN_X]; const float* cin = ap->in[IN_CTX];
            if (l == 0) norm1_rows<true, false>(X, l, XR, Hb, Yg, modp, tok_slot, tok_w, gain, xin, cin, tid);
            else if (prev_moe) norm1_rows<false, true>(X, l, XR, Hb, Yg, modp, tok_slot, tok_w, gain, xin, cin, tid);
            else norm1_rows<false, false>(X, l, XR, Hb, Yg, modp, tok_slot, tok_w, gain, xin, cin, tid);
            if (l == 2) { __syncthreads(); int base = 0; cvt_moe_layer(X, base, ap->in[IN_MW1], ap->in[IN_MW3], ap->in[IN_MW2], ws, 1); }
        }
        STEP_END;
        if (STEP_ON(2)) {
            PHASE_VARS;
            pg8::Gemm g{(const bf16_t*)(ws + WS_H), (const bf16_t*)(ws + WS_WSM + (size_t)l * LW + OFF_WIN), D, D, D}; pg8::StaticOrder S{T / 256, DINP / 256, X.G, bx_};
            pg8::EpiIn E{(bf16_t*)(ws + WS_Y), (float*)(ws + WS_SSQ_Q), (float*)(ws + WS_SSQ_KV), (bf16_t*)(ws + WS_KM), (const float*)(ws + WS_ROPE_MLA), (const float*)(ws + WS_ROPE_GQA), ap->in[IN_GQG] + l * 64, ap->in[IN_GKG] + l * 64};
            pg8::gemm_phase<pg8::EpiIn, pg8::StaticOrder, true, true>(lds, g, S, E, tid);
        }
        STEP_END;
        if (STEP_ON(4)) {
            PHASE_VARS;
            const bf16_t* Yb = (const bf16_t*)(ws + WS_Y); const unsigned char* wl = ws + WS_WSM + (size_t)l * LW;
            static_assert(OFF_WKVB == OFF_WQB + (size_t)768 * 384 * 2, "one weight image");
            pg8::Gemm g{Yb + C_QC, (const bf16_t*)(wl + OFF_WQB), DINP, 384, 384}; pg8::QKVOrder S{last ? NB * 32 : T / 256, T / 256, X.G, bx_, C_KVC * 2, last};
            pg8::EpiQKV E{{(bf16_t*)(ws + WS_QM), (const float*)(ws + WS_ROPE_MLA), (const float*)(ws + WS_SSQ_Q)}, {(bf16_t*)(ws + WS_KM), (bf16_t*)(ws + WS_VM), (const float*)(ws + WS_SSQ_KV)}};
            pg8::gemm_phase<pg8::EpiQKV, pg8::QKVOrder, true, true>(lds, g, S, E, tid);
        }
        STEP_END;
        if (STEP_ON(5)) {
            PHASE_VARS;
            bf16_t* Yb = (bf16_t*)(ws + WS_Y); bf16_t* Qm = (bf16_t*)(ws + WS_QM); bf16_t* Km = (bf16_t*)(ws + WS_KM); bf16_t* Vm = (bf16_t*)(ws + WS_VM);
            bf16_t* Om = (bf16_t*)(ws + WS_OM); bf16_t* Og = (bf16_t*)(ws + WS_OG);
            const float Cm = 0.10206207261596575f * LOG2E, Cg = 0.125f * LOG2E;
#define ATT_DECODE(L) \
                int b, h, q0, nt; bool gqa; \
                if (L < 2048) { const int pr = (int)(L / 256) * 8 + (int)(L % 8), qb = (int)(L / 8) % 32; q0 = NCTX + qb * 256; nt = TPB / 64; \
                    if (pr < 32) { const int x8 = pr & 7, g = pr >> 3; gqa = true; b = x8 >> 1; h = (x8 & 1) * 4 + g; } \
                    else { const int p2 = pr - 32; gqa = false; b = p2 >> 3; h = p2 & 7; } } \
                else { const int c = (int)(L - 2048); gqa = c < 32; b = (c >> 3) & 3; h = c & 7; q0 = 0; nt = NCTX / 64; } \
                const size_t r0 = (size_t)b * TPB;
            for (int i = 0;; ++i) {
                const long L = (long)i * X.G + bx_; if (L >= (last ? 2048 : 2048 + 64)) break;
                ATT_DECODE(L)
                bool bad;
                if (gqa) { const int kvh = h >> 2;
                    bad = att2::attn_unit<64>(Yb + (r0 + q0) * DINP + C_QG + h * 64, DINP, Yb + r0 * DINP + C_KG + kvh * 64, DINP, Yb + r0 * DINP + C_VG + kvh * 64, DINP,
                                              Og + (r0 + q0) * 512 + h * 64, 512, nt, (LAS char*)lds, tid);
                } else {
                    bad = att2::attn_unit<96>(Qm + (r0 + q0) * 768 + h * 96, 768, Km + r0 * 768 + h * 96, 768, Vm + r0 * 512 + h * 64, 512,
                                              Om + (r0 + q0) * 512 + h * 64, 512, nt, (LAS char*)lds, tid);
                }
                if (bad && lane == 0) __hip_atomic_fetch_or((LAS unsigned*)(LC + 60), 1u << i, __ATOMIC_RELAXED, __HIP_MEMORY_SCOPE_WORKGROUP);
                asm volatile("s_waitcnt lgkmcnt(0)\n\ts_barrier" ::: "memory");
            }
            const unsigned redo = LC[60];
            if (redo != 0u) {
                for (int i = 0; i < 32; ++i) { if (!((redo >> i) & 1u)) continue;
                    const long L = (long)i * X.G + bx_;
                    ATT_DECODE(L)
                    if (gqa) { const int kvh = h >> 2;
                        att::attn_unit<64>(Yb + (r0 + q0) * DINP + C_QG + h * 64, DINP, Yb + r0 * DINP + C_KG + kvh * 64, DINP, Yb + r0 * DINP + C_VG + kvh * 64, DINP,
                                           Og + (r0 + q0) * 512 + h * 64, 512, nt, 1.0f, 8.0f, (LAS char*)lds, tid);
                    } else {
                        att::attn_unit<96>(Qm + (r0 + q0) * 768 + h * 96, 768, Km + r0 * 768 + h * 96, 768, Vm + r0 * 512 + h * 64, 512,
                                           Om + (r0 + q0) * 512 + h * 64, 512, nt, 1.0f, 8.0f, (LAS char*)lds, tid);
                    }
                }
                __syncthreads(); if (tid == 0) LC[60] = 0u;
            }
#undef ATT_DECODE
            __syncthreads();
        }
        STEP_END;
        if (STEP_ON(6)) {
            PHASE_VARS;
            static_assert(WS_OG == WS_OM + (size_t)T * 512 * 2 && OFF_WOG == OFF_WOM + (size_t)1024 * 512 * 2, "pair layout");
            pg8::Gemm g{(const bf16_t*)(ws + WS_OM), (const bf16_t*)(ws + WS_WSM + (size_t)l * LW + OFF_WOM), 512, 512, 512}; pg8::PairOrder S{last ? NB * 32 : T / 256, 4, X.G, bx_, T / 256, 4, last};
            pg8::EpiGate2 E{(bf16_t*)(ws + WS_MG), (const bf16_t*)(ws + WS_Y) + C_GM, (const bf16_t*)(ws + WS_Y) + C_GG}; pg8::gemm_phase<pg8::EpiGate2, pg8::PairOrder, true, true>(lds, g, S, E, tid);
        }
        STEP_END;
        if (STEP_ON(8)) {
            PHASE_VARS;
            pg8::Gemm g{(const bf16_t*)(ws + WS_MG), (const bf16_t*)(ws + WS_WSM + (size_t)l * LW + OFF_WOUT), D, D, D}; pg8::StaticOrder S{last ? NB * 32 : T / 256, 4, X.G, bx_, last};
            pg8::EpiRes E{(bf16_t*)(ws + WS_XR), (const float*)(ws + WS_MOD) + (size_t)l * 5 * 6 * D + 2 * D}; pg8::gemm_phase<pg8::EpiRes, pg8::StaticOrder, true, true>(lds, g, S, E, tid);
        }
        STEP_END;
        if (STEP_ON(9)) {
            PHASE_VARS;
            const bf16_t* XR = (const bf16_t*)(ws + WS_XR); bf16_t* Hb = (bf16_t*)(ws + WS_H); const float* modl = (const float*)(ws + WS_MOD) + (size_t)l * 5 * 6 * D;
            int* cntb = (int*)(ws + WS_CNTB); unsigned* tok_e = (unsigned*)(ws + WS_TOK_E); i32x2* tok_pos = (i32x2*)(ws + WS_TOK_POS); f32x2* tok_w = (f32x2*)(ws + WS_TOK_W);
            const float* gain = ap->in[IN_N2G] + l * D; const float* router = ap->in[IN_ROUTER] + (size_t)(l >> 1) * D * NE;
            f32x4 rt[32];
            if (moe) { if (tid < 8) LC[16 + tid] = 0u;
#pragma unroll
                for (int j = 0; j < 4; ++j)
#pragma unroll
                    for (int qq = 0; qq < 8; ++qq) rt[j * 8 + qq] = ((const f32x4*)(router + (size_t)(4 * (lane + 64 * j)) * NE))[qq]; }
            else {
#pragma unroll
                for (int i = 0; i < 32; ++i) rt[i] = (f32x4){0.f, 0.f, 0.f, 0.f}; }
            lds_fill(lds + TL_GAIN, gain, D / 4, tid);
            for (int v = 0; v < 5; ++v) lds_fill(lds + TL_MOD + v * 8192, modl + ((size_t)v * 6 + 3) * D, 2 * D / 4, tid);
            __syncthreads();
            constexpr int NG = 3;
            u32x2 xn[NG][4];
#pragma unroll
            for (int q = 0; q < NG; ++q) { int r = X.gw + q * X.NGW; r = r < T ? r : T - 1;
#pragma unroll
                for (int j = 0; j < 4; ++j) xn[q][j] = ((const u32x2*)(XR + (size_t)r * D))[lane + 64 * j]; }
            for (int row0 = X.gw; row0 < T; row0 += NG * X.NGW) {
                u32x2 xc[NG][4];
#pragma unroll
                for (int q = 0; q < NG; ++q)
#pragma unroll
                    for (int j = 0; j < 4; ++j) xc[q][j] = xn[q][j];
#pragma unroll
                for (int q = 0; q < NG; ++q) { int r = row0 + (NG + q) * X.NGW; r = r < T ? r : T - 1;
#pragma unroll
                    for (int j = 0; j < 4; ++j) xn[q][j] = ((const u32x2*)(XR + (size_t)r * D))[lane + 64 * j]; }
#pragma unroll
                for (int q = 0; q < NG; ++q) {
                const int row = row0 + q * X.NGW; if (row >= T) break;
                const int b = row / TPB, t = row - b * TPB, v = t < NCTX ? 4 : b;
                if (last && t < NCTX) continue;
                f32x4 x[4]; float ss = 0.f;
#pragma unroll
                for (int j = 0; j < 4; ++j) { x[j] = bf4(xc[q][j]); ss += (x[j][0] * x[j][0] + x[j][1] * x[j][1]) + (x[j][2] * x[j][2] + x[j][3] * x[j][3]); }
                const float rstd = 1.0f / sqrtf(wave_sum(ss) * (1.0f / D) + EPS);
                const LAS f32x4* gl = (const LAS f32x4*)(lds + TL_GAIN); const LAS f32x4* sh = (const LAS f32x4*)(lds + TL_MOD + v * 8192); const LAS f32x4* sc = sh + D / 4;
                float lg0 = 0.f, lg1 = 0.f, lg2 = 0.f, lg3 = 0.f, lg4 = 0.f, lg5 = 0.f, lg6 = 0.f, lg7 = 0.f;
#pragma unroll
                for (int j = 0; j < 4; ++j) { const f32x4 g = gl[lane + 64 * j], s1 = sc[lane + 64 * j], s0 = sh[lane + 64 * j];
                    const f32x4 h = (x[j] * rstd * g) * (s1 + 1.0f) + s0; u32x2 o; o.x = cvt_pk_bf16(h[0], h[1]); o.y = cvt_pk_bf16(h[2], h[3]);
                    ((u32x2*)(Hb + (size_t)row * D))[lane + 64 * j] = o;
                    if (moe) {
#pragma unroll
                        for (int qq = 0; qq < 4; ++qq) { const f32x4 r0 = rt[j * 8 + 2 * qq], r1 = rt[j * 8 + 2 * qq + 1];
                            lg0 += h[qq] * r0[0]; lg1 += h[qq] * r0[1]; lg2 += h[qq] * r0[2]; lg3 += h[qq] * r0[3];
                            lg4 += h[qq] * r1[0]; lg5 += h[qq] * r1[1]; lg6 += h[qq] * r1[2]; lg7 += h[qq] * r1[3]; } } }
                if (moe) {
                    {
                        float t0, t1, t2, t3;
                        { auto r = __builtin_amdgcn_permlane32_swap(__float_as_uint(lg0), __float_as_uint(lg4), false, false); t0 = __uint_as_float(r[0]) + __uint_as_float(r[1]); }
                        { auto r = __builtin_amdgcn_permlane32_swap(__float_as_uint(lg1), __float_as_uint(lg5), false, false); t1 = __uint_as_float(r[0]) + __uint_as_float(r[1]); }
                        { auto r = __builtin_amdgcn_permlane32_swap(__float_as_uint(lg2), __float_as_uint(lg6), false, false); t2 = __uint_as_float(r[0]) + __uint_as_float(r[1]); }
                        { auto r = __builtin_amdgcn_permlane32_swap(__float_as_uint(lg3), __float_as_uint(lg7), false, false); t3 = __uint_as_float(r[0]) + __uint_as_float(r[1]); }
                        const bool b4 = (lane & 16) != 0, b3 = (lane & 8) != 0;
                        const float u0 = (b4 ? t2 : t0) + lane_xor<16>(b4 ? t0 : t2), u1 = (b4 ? t3 : t1) + lane_xor<16>(b4 ? t1 : t3);
                        float w = (b3 ? u1 : u0) + lane_xor<8>(b3 ? u0 : u1);
                        w += lane_xor<4>(w); w += lane_xor<2>(w); w += lane_xor<1>(w);
                        const int wi = (int)__float_as_uint(w);
                        lg0 = __uint_as_float((unsigned)__builtin_amdgcn_readlane(wi, 0));  lg1 = __uint_as_float((unsigned)__builtin_amdgcn_readlane(wi, 8));
                        lg2 = __uint_as_float((unsigned)__builtin_amdgcn_readlane(wi, 16)); lg3 = __uint_as_float((unsigned)__builtin_amdgcn_readlane(wi, 24));
                        lg4 = __uint_as_float((unsigned)__builtin_amdgcn_readlane(wi, 32)); lg5 = __uint_as_float((unsigned)__builtin_amdgcn_readlane(wi, 40));
                        lg6 = __uint_as_float((unsigned)__builtin_amdgcn_readlane(wi, 48)); lg7 = __uint_as_float((unsigned)__builtin_amdgcn_readlane(wi, 56));
                    }
                    float v1 = lg0; int i1 = 0;
#define TOP1(e, x_) if (x_ > v1) { v1 = x_; i1 = e; }
                    TOP1(1, lg1) TOP1(2, lg2) TOP1(3, lg3) TOP1(4, lg4) TOP1(5, lg5) TOP1(6, lg6) TOP1(7, lg7)
#undef TOP1
                    float v2 = -INFINITY; int i2 = 0;
#define TOP2(e, x_) if (i1 != e && x_ > v2) { v2 = x_; i2 = e; }
                    TOP2(0, lg0) TOP2(1, lg1) TOP2(2, lg2) TOP2(3, lg3) TOP2(4, lg4) TOP2(5, lg5) TOP2(6, lg6) TOP2(7, lg7)
#undef TOP2
                    const float ex = __expf(v2 - v1), w1 = 1.0f / (1.0f + ex), w2 = ex * w1;
                    if (lane == 0) { const int pa = (int)__hip_atomic_fetch_add((LAS unsigned*)(LC + 16 + i1), 1u, __ATOMIC_RELAXED, __HIP_MEMORY_SCOPE_WORKGROUP);
                        const int pb = (int)__hip_atomic_fetch_add((LAS unsigned*)(LC + 16 + i2), 1u, __ATOMIC_RELAXED, __HIP_MEMORY_SCOPE_WORKGROUP);
                        tok_e[row] = (unsigned)i1 | ((unsigned)i2 << 8); tok_pos[row] = (i32x2){pa, pb}; tok_w[row] = (f32x2){w1, w2}; }
                }
                }
            }
            if (moe) { __syncthreads(); if (tid < 8) cntb[X.vcu * 8 + tid] = (int)LC[16 + tid]; }
        }
        STEP_END;
        if (!moe) {
            if (STEP_ON(10)) {
                PHASE_VARS;
                pg8::Gemm g{(const bf16_t*)(ws + WS_H), (const bf16_t*)(ws + WS_WDEN + (size_t)(l >> 1) * LWD), D, D, D}; pg8::StaticOrder S{T / 256, 2 * FD / 256, X.G, bx_};
                pg8::EpiSwiglu E{(bf16_t*)(ws + WS_HH), FD, 0}; pg8::gemm_phase<pg8::EpiSwiglu, pg8::StaticOrder, true, true>(lds, g, S, E, tid);
            }
            STEP_END;
            if (STEP_ON(11)) {
                PHASE_VARS;
                pg8::Gemm g{(const bf16_t*)(ws + WS_HH), (const bf16_t*)(ws + WS_WDEN + (size_t)(l >> 1) * LWD + SZ_W13D), FD, FD, FD}; pg8::StaticOrder S{T / 256, 4, X.G, bx_};
                pg8::EpiRes E{(bf16_t*)(ws + WS_XR), (const float*)(ws + WS_MOD) + (size_t)l * 5 * 6 * D + 5 * D}; pg8::gemm_phase<pg8::EpiRes, pg8::StaticOrder, true, true>(lds, g, S, E, tid);
            }
            STEP_END;
        } else {
            if (STEP_ON(12)) {
                PHASE_VARS;
                const int* cntb = (const int*)(ws + WS_CNTB); int* meta = (int*)(ws + WS_META);
                const unsigned* tok_e = (const unsigned*)(ws + WS_TOK_E); const i32x2* tok_pos = (const i32x2*)(ws + WS_TOK_POS); i32x2* tok_slot = (i32x2*)(ws + WS_TOK_SLOT);
                const bf16_t* Hb = (const bf16_t*)(ws + WS_H); bf16_t* Xg = (bf16_t*)(ws + WS_XG);
                { const int e = X.wave; int tot = 0, pre = 0;
                  for (int b0 = 0; b0 < X.G; b0 += 64) { const int bb = b0 + lane; const int c = bb < X.G ? cntb[bb * 8 + e] : 0; tot += c; pre += (bb < X.vcu) ? c : 0; }
                  tot = (int)wave_sum((float)tot); pre = (int)wave_sum((float)pre);
                  if (lane == 0) { LC[24 + e] = (unsigned)tot; LC[32 + e] = (unsigned)pre; } }
                __syncthreads();
                if (tid == 0) { int pbase = 0;
                    for (int e = 0; e < 8; ++e) { const int tot = (int)LC[24 + e], np = (tot + 255) >> 8; LC[40 + e] = (unsigned)(pbase * 256 + (int)LC[32 + e]); pbase += np; LC[48 + e] = (unsigned)pbase; } }
                __syncthreads();
                if (X.vcu == 0 && tid < MAXPAN) { int e = 0;
#pragma unroll
                    for (int q = 0; q < 8; ++q) e += ((int)LC[48 + q] <= tid) ? 1 : 0;
                    meta[16 + tid] = e < 8 ? e : 7; if (tid == 0) meta[0] = (int)LC[55]; }
                unsigned een; i32x2 ppn; u32x4 v0n, v1n;
                { const int row0 = X.gw < T ? X.gw : T - 1; een = tok_e[row0]; ppn = tok_pos[row0]; const u32x4* src = (const u32x4*)(Hb + (size_t)row0 * D); v0n = src[lane]; v1n = src[lane + 64]; }
                for (int row = X.gw; row < T; row += X.NGW) {
                    const unsigned ee = een; const i32x2 pp = ppn; const u32x4 v0 = v0n, v1 = v1n;
                    { const int nrow = row + X.NGW; if (nrow < T) { een = tok_e[nrow]; ppn = tok_pos[nrow]; const u32x4* src = (const u32x4*)(Hb + (size_t)nrow * D); v0n = src[lane]; v1n = src[lane + 64]; } }
                    if (last && (row % TPB) < NCTX) continue;
                    const int sa = (int)LC[40 + (ee & 0xff)] + pp.x, sb = (int)LC[40 + ((ee >> 8) & 0xff)] + pp.y;
                    u32x4* da = (u32x4*)(Xg + (size_t)sa * D); u32x4* db = (u32x4*)(Xg + (size_t)sb * D);
                    da[lane] = v0; da[lane + 64] = v1; db[lane] = v0; db[lane + 64] = v1;
                    if (lane == 0) tok_slot[row] = (i32x2){sa, sb};
                }
            }
            STEP_END;
            for (int ch = 0; ch < MOE_NCH; ++ch) {
                if (STEP_ON(13)) {
                    PHASE_VARS;
                    const int* meta = (const int*)(ws + WS_META);
                    const int P = __builtin_amdgcn_readfirstlane(meta[0]); int np = P - ch * MOE_CH; np = np > MOE_CH ? MOE_CH : np;
                    pg8::Gemm g{(const bf16_t*)(ws + WS_XG), (const bf16_t*)(ws + WS_WMOE13), D, D, D}; pg8::MoeOrder S{ch * MOE_CH, np, 2 * FE / 256, X.G, bx_, 0, meta + 16};
                    pg8::EpiSwiglu E{(bf16_t*)(ws + WS_HHG), FE, ch * MOE_CH}; pg8::gemm_phase<pg8::EpiSwiglu, pg8::MoeOrder, true, true>(lds, g, S, E, tid);
                }
                STEP_END;
                if (STEP_ON(14)) {
                    PHASE_VARS;
                    const int* meta = (const int*)(ws + WS_META);
                    const int P = __builtin_amdgcn_readfirstlane(meta[0]); int np = P - ch * MOE_CH; np = np > MOE_CH ? MOE_CH : np;
                    pg8::Gemm g{(const bf16_t*)(ws + WS_HHG), (const bf16_t*)(ws + WS_WMOE2), FE, FE, FE}; pg8::MoeOrder S{ch * MOE_CH, np, 4, X.G, bx_, ch * MOE_CH, meta + 16};
                    pg8::EpiBf16 E{(bf16_t*)(ws + WS_YG), D, 1 << 30, 0}; pg8::gemm_phase<pg8::EpiBf16, pg8::MoeOrder, true, true>(lds, g, S, E, tid);
                }
                STEP_END;
            }
        }
    }
    if (STEP_ON(15)) {
        PHASE_VARS;
        const bf16_t* XR = (const bf16_t*)(ws + WS_XR); const bf16_t* Yg = (const bf16_t*)(ws + WS_YG); const float* modp = (const float*)(ws + WS_MOD);
        const i32x2* tok_slot = (const i32x2*)(ws + WS_TOK_SLOT); const f32x2* tok_w = (const f32x2*)(ws + WS_TOK_W);
        const float* gain = ap->in[IN_FNG]; float* outp = ap->out;
        lds_fill(lds + TL_GAIN, gain, D / 4, tid);
        for (int v = 0; v < 4; ++v) lds_fill(lds + TL_G2 + v * 4096, modp + ((size_t)((DEPTH - 1) * 5 + v) * 6 + 5) * D, D / 4, tid);
        __syncthreads();
        auto next_lat = [&](int row) { while (row < T && (row % TPB) < NCTX) row += X.NGW; return row; };
        u32x2 xn[4]; i32x2 sln; f32x2 wn;
        int row = next_lat(X.gw);
        { const int row0 = row < T ? row : T - 1;
#pragma unroll
            for (int j = 0; j < 4; ++j) xn[j] = ((const u32x2*)(XR + (size_t)row0 * D))[lane + 64 * j];
            sln = tok_slot[row0]; wn = tok_w[row0]; }
        while (row < T) {
            const int b = row / TPB, t = row - b * TPB;
            f32x4 x[4]; const i32x2 sl = sln; const f32x2 w = wn; u32x2 ya[4], yb[4];
#pragma unroll
            for (int j = 0; j < 4; ++j) { x[j] = bf4(xn[j]); ya[j] = ((const u32x2*)(Yg + (size_t)sl.x * D))[lane + 64 * j]; yb[j] = ((const u32x2*)(Yg + (size_t)sl.y * D))[lane + 64 * j]; }
            const int nrow = next_lat(row + X.NGW);
            if (nrow < T) {
#pragma unroll
                for (int j = 0; j < 4; ++j) xn[j] = ((const u32x2*)(XR + (size_t)nrow * D))[lane + 64 * j];
                sln = tok_slot[nrow]; wn = tok_w[nrow]; }
            { const LAS f32x4* g2 = (const LAS f32x4*)(lds + TL_G2 + b * 4096);
#pragma unroll
              for (int j = 0; j < 4; ++j) { const f32x4 g = g2[lane + 64 * j];
                  x[j][0] += g[0] * (w.x * bflo(ya[j].x) + w.y * bflo(yb[j].x)); x[j][1] += g[1] * (w.x * bfhi(ya[j].x) + w.y * bfhi(yb[j].x));
                  x[j][2] += g[2] * (w.x * bflo(ya[j].y) + w.y * bflo(yb[j].y)); x[j][3] += g[3] * (w.x * bfhi(ya[j].y) + w.y * bfhi(yb[j].y)); } }
            float ss = 0.f;
#pragma unroll
            for (int j = 0; j < 4; ++j) ss += (x[j][0] * x[j][0] + x[j][1] * x[j][1]) + (x[j][2] * x[j][2] + x[j][3] * x[j][3]);
            const float rstd = 1.0f / sqrtf(wave_sum(ss) * (1.0f / D) + EPS);
            float* orow = outp + ((size_t)b * SEQ + (t - NCTX)) * D;
#pragma unroll
            for (int j = 0; j < 4; ++j) { const f32x4 g = ((const LAS f32x4*)(lds + TL_GAIN))[lane + 64 * j]; ((f32x4*)orow)[lane + 64 * j] = x[j] * rstd * g; }
            row = nrow;
        }
    }
    STEP_END;
#undef STEP_ON
#undef STEP_END
#undef PHASE_VARS
}

constexpr int NSTEPS = 1 + DEPTH * 7 + 2 * 2 + 2 * (1 + 2 * MOE_NCH) + 1;
extern "C" void kernel_launch(void* const* d_in, const int* in_sizes, int n_in, void* d_out, int out_size, void* d_ws, size_t ws_size, hipStream_t stream) {
    static int grid = 0;
    if (grid == 0) {
        if (n_in != 26 || in_sizes[0] != NB * SEQ * D || out_size != NB * SEQ * D || ws_size < WS_END) {
            fprintf(stderr, "kernel_launch: shape mismatch: n_in %d in0 %d out %d ws %zu (need >= %zu)\n", n_in, n_in > 0 ? in_sizes[0] : -1, out_size, ws_size, (size_t)WS_END); grid = -1; return; }
        int dev = 0, cus = 0, per_cu = 0;
        if (hipGetDevice(&dev) != hipSuccess || hipDeviceGetAttribute(&cus, hipDeviceAttributeMultiprocessorCount, dev) != hipSuccess) { fprintf(stderr, "kernel_launch: device query failed\n"); grid = -1; return; }
        if (hipFuncSetAttribute((const void*)mega_fwd, hipFuncAttributeMaxDynamicSharedMemorySize, LDS_BYTES) != hipSuccess) { fprintf(stderr, "kernel_launch: hipFuncSetAttribute failed\n"); grid = -1; return; }
        if (hipOccupancyMaxActiveBlocksPerMultiprocessor(&per_cu, (const void*)mega_fwd, 512, LDS_BYTES) != hipSuccess || per_cu < 1)
            fprintf(stderr, "kernel_launch: note: occupancy query reports %d workgroups per CU\n", per_cu);
        (void)hipGetLastError();
        grid = cus;
    }
    if (grid < 0) return;
    if (hipMemsetAsync((char*)d_ws + WS_CTL, 0, CTL_ZERO_BYTES, stream) != hipSuccess) { fprintf(stderr, "kernel_launch: memset failed\n"); return; }
    Args a{};
    for (int i = 0; i < 26; ++i) a.in[i] = (const float*)d_in[i];
    a.out = (float*)d_out; a.ws = (unsigned char*)d_ws;
    for (int f = 0; f < 8; ++f) a.inv_mla[f] = powf(10000.0f, -((float)f * 2.0f) / 16.0f);
    for (int f = 0; f < 16; ++f) a.inv_gqa[f] = powf(10000.0f, -((float)f * 2.0f) / 32.0f);
#if MK_MULTI
    for (int s = 0; s < NSTEPS; ++s) { a.ph_lo = s; a.ph_hi = s + 1; hipLaunchKernelGGL(mega_fwd, dim3(grid), dim3(512), LDS_BYTES, stream, a); }
#else
    a.ph_lo = 0; a.ph_hi = NSTEPS;
    hipLaunchKernelGGL(mega_fwd, dim3(grid), dim3(512), LDS_BYTES, stream, a);
#endif
    const hipError_t le = hipPeekAtLastError();
    if (le != hipSuccess) fprintf(stderr, "kernel_launch: launch failed: %s\n", hipGetErrorName(le));
}
```

```cpp
#include <hip/hip_runtime.h>
#include <cstdio>
#include <cstdint>
#include <cmath>

#ifndef MK_MULTI
#define MK_MULTI 0
#endif

#define LAS __attribute__((address_space(3)))
#define GAS __attribute__((address_space(1)))
typedef unsigned short bf16_t;
typedef short bf16x8 __attribute__((ext_vector_type(8)));
typedef short s16x4 __attribute__((ext_vector_type(4)));
typedef float f32x2 __attribute__((ext_vector_type(2)));
typedef float f32x4 __attribute__((ext_vector_type(4)));
typedef float f32x16 __attribute__((ext_vector_type(16)));
typedef unsigned u32x2 __attribute__((ext_vector_type(2)));
typedef unsigned u32x4 __attribute__((ext_vector_type(4)));
typedef int i32x2 __attribute__((ext_vector_type(2)));

constexpr int D = 1024, NB = 4, SEQ = 8192, NCTX = 256, TPB = SEQ + NCTX  , T = NB * TPB  , DEPTH = 4;
constexpr int PPB = TPB / 256;
constexpr int DINP = 3584;
constexpr int C_QC = 0, C_KVC = 384, C_KPE = 640, C_QG = 768, C_KG = 1280, C_VG = 1408, C_GM = 1536, C_GG = 2560;
constexpr int FD = 2816, FE = 3584, NE = 8;
constexpr float EPS = 1e-6f;
constexpr float LOG2E = 1.4426950408889634f;
constexpr int MOE_CH = 64;
constexpr int MOE_NCH = 5;
constexpr int MAXPAN = 272;

constexpr size_t MiB = 1u << 20;
constexpr size_t WS_CTL = 0, CTL_ZERO_BYTES = 2 * MiB;
constexpr size_t WS_ROPE_MLA = 2 * MiB, WS_ROPE_GQA = 2 * MiB + 16384, WS_MOD = 2 * MiB + 65536;
constexpr size_t WS_CNTB = 3 * MiB, WS_META = 3 * MiB + 65536;
constexpr size_t WS_TOK_E = 4 * MiB, WS_TOK_POS = 4 * MiB + 512 * 1024, WS_TOK_W = 5 * MiB, WS_TOK_SLOT = 5 * MiB + 512 * 1024;
constexpr size_t WS_WSM = 8 * MiB;
constexpr size_t SZ_WIN = (size_t)DINP * D * 2, SZ_WQB = 768 * 384 * 2, SZ_WKVB = 1024 * 256 * 2, SZ_WO = 1024 * 512 * 2, SZ_WOUT = 1024 * 1024 * 2;
constexpr size_t OFF_WIN = 0, OFF_WQB = OFF_WIN + SZ_WIN, OFF_WKVB = OFF_WQB + SZ_WQB, OFF_WOM = OFF_WKVB + SZ_WKVB, OFF_WOG = OFF_WOM + SZ_WO, OFF_WOUT = OFF_WOG + SZ_WO, LW = OFF_WOUT + SZ_WOUT;
constexpr size_t WS_WDEN = 58 * MiB, SZ_W13D = (size_t)2 * FD * D * 2, SZ_W2D = (size_t)D * FD * 2, LWD = SZ_W13D + SZ_W2D;
constexpr size_t WS_WMOE13 = 92 * MiB, WS_WMOE2 = 204 * MiB;
constexpr size_t WS_XR = 260 * MiB;
constexpr size_t WS_BIG = 392 * MiB;
constexpr size_t WS_H = WS_BIG, WS_OM = WS_BIG, WS_OG = WS_BIG + 33 * MiB;
constexpr size_t WS_Y = WS_BIG + 66 * MiB;
constexpr size_t WS_QM = WS_BIG + 297 * MiB, WS_KM = WS_QM + (size_t)T * 768 * 2, WS_VM = WS_KM + (size_t)T * 768 * 2, WS_MG = WS_QM;
constexpr size_t WS_HH = WS_BIG + 66 * MiB;
constexpr size_t WS_XG = WS_BIG + 66 * MiB, WS_HHG = WS_BIG + 202 * MiB, WS_YG = WS_BIG + 314 * MiB;
constexpr size_t WS_SSQ_Q = WS_BIG + 450 * MiB, WS_SSQ_KV = WS_SSQ_Q + 2 * MiB;
constexpr size_t WS_END = WS_BIG + 454 * MiB;
static_assert(WS_WSM + 4 * LW <= WS_WDEN && WS_WDEN + 2 * LWD <= WS_WMOE13, "small weights");
static_assert(WS_WMOE13 + (size_t)NE * 2 * FE * D * 2 <= WS_WMOE2 && WS_WMOE2 + (size_t)NE * D * FE * 2 <= WS_XR, "moe weights");
static_assert(WS_XR + (size_t)T * D * 4 <= WS_BIG, "xr");
static_assert(WS_H + (size_t)T * D * 2 <= WS_Y && WS_Y + (size_t)T * DINP * 2 <= WS_QM && WS_VM + (size_t)T * 512 * 2 <= WS_END, "attn stage");
static_assert(WS_HH + (size_t)T * FD * 2 <= WS_END, "dense stage");
static_assert(WS_XG + (size_t)MAXPAN * 256 * D * 2 <= WS_HHG && WS_HHG + (size_t)MOE_CH * 256 * FE * 2 <= WS_YG && WS_YG + (size_t)MAXPAN * 256 * D * 2 <= WS_END, "moe stage");
static_assert(WS_MOD + (size_t)DEPTH * 5 * 6 * D * 4 <= WS_CNTB, "mod");
constexpr int CW_BAR = 4096;

constexpr int RING_BYTES = 131072;
constexpr int LDSCTL_OFF = RING_BYTES;
constexpr int LDS_BYTES = 147456;

__device__ __forceinline__ unsigned cvt_pk_bf16(float lo, float hi) { unsigned r; asm volatile("v_cvt_pk_bf16_f32 %0, %1, %2" : "=v"(r) : "v"(lo), "v"(hi)); return r; }
__device__ __forceinline__ float bflo(unsigned w) { return __uint_as_float(w << 16); }
__device__ __forceinline__ float bfhi(unsigned w) { return __uint_as_float(w & 0xffff0000u); }
__device__ __forceinline__ float bf1(bf16_t h) { return __uint_as_float((unsigned)h << 16); }
__device__ __forceinline__ f32x4 bf4(u32x2 w) { return (f32x4){bflo(w.x), bfhi(w.x), bflo(w.y), bfhi(w.y)}; }
__device__ __forceinline__ float fast_sigmoid(float x) { return __builtin_amdgcn_rcpf(1.0f + __builtin_amdgcn_exp2f(-x * LOG2E)); }
template <int M> __device__ __forceinline__ float lane_xor(float v) {
    if constexpr (M == 32) { auto rr = __builtin_amdgcn_permlane32_swap(__float_as_uint(v), __float_as_uint(v), false, false); return __uint_as_float((threadIdx.x & 32) ? rr[0] : rr[1]); }
    else return __uint_as_float((unsigned)__builtin_amdgcn_ds_swizzle((int)__float_as_uint(v), (M << 10) | 0x1f));
}
__device__ __forceinline__ float wave_sum(float v) {
    v += lane_xor<1>(v); v += lane_xor<2>(v); v += lane_xor<4>(v); v += lane_xor<8>(v); v += lane_xor<16>(v);
    { auto rr = __builtin_amdgcn_permlane32_swap(__float_as_uint(v), __float_as_uint(v), false, false); v = __uint_as_float(rr[0]) + __uint_as_float(rr[1]); }
    return v;
}

namespace pg8 {
constexpr int BM = 256, BK = 64, HALF = 128, HTB = HALF * BK * 2, STAGE_BYTES = 8 * HTB, NXCD = 8, WGM = 8;
__host__ __device__ __forceinline__ int lds_byte(int r, int c) { const int st = (r >> 4) * 2 + (c >> 5), rr = r & 15, cc = c & 31, ob = rr * 64 + cc * 2; return st * 1024 + (ob ^ (((ob >> 9) & 1) << 5)); }
__host__ __device__ __forceinline__ void stage_rc(int b, int& R, int& C) { const int st = b / 1024, sb = b % 1024, swz = sb ^ (((sb >> 9) & 1) << 5); R = (st >> 1) * 16 + swz / 64; C = (st & 1) * 32 + (swz % 64) / 2; }
__host__ __device__ __forceinline__ int perm32(int rho) { const int n = rho >> 4, i = rho & 15; return 8 * (i >> 2) + 4 * n + (i & 3); }

struct Unit { int pa, pb, pm, pn; };
struct Gemm { const bf16_t* A; const bf16_t* Bt; int lda, ldb, K; };

__device__ __forceinline__ bool tile_order(long L, int nM, int nN, int& pm, int& pn) {
    const int nwg = nM * nN; if (L >= nwg) return false;
    int wgid = (int)L; { const int q = nwg / NXCD, r = nwg % NXCD, xcd = wgid % NXCD, off = wgid / NXCD; wgid = (xcd < r ? xcd * (q + 1) : r * (q + 1) + (xcd - r) * q) + off; }
    const int nig = WGM * nN, gid = wgid / nig, fm = gid * WGM, gsz = (nM - fm) < WGM ? (nM - fm) : WGM;
    pm = fm + ((wgid % nig) % gsz); pn = (wgid % nig) / gsz; return true;
}
struct StaticOrder {
    static constexpr bool PAIRED = false;
    int nM, nN, G, c; int latent_only = 0;
    __device__ __forceinline__ bool next(int i, Unit& u) const {
        int pm, pn; if (!tile_order((long)i * G + c, nM, nN, pm, pn)) return false;
        if (latent_only) pm += (pm >> 5) + 1;
        u.pa = pm; u.pb = pn; u.pm = pm; u.pn = pn; return true;
    }
};
struct MoeOrder {
    static constexpr bool PAIRED = false;
    int p0, np, nN, G, c, aoff; const int* pexp;
    __device__ __forceinline__ bool next(int i, Unit& u) const {
        if (np <= 0) return false;
        int pm, pn; if (!tile_order((long)i * G + c, np, nN, pm, pn)) return false;
        pm += p0; const int e = __builtin_amdgcn_readfirstlane(pexp[pm]);
        u.pa = pm - aoff; u.pb = e * nN + pn; u.pm = pm; u.pn = pn; return true;
    }
};

struct PairOrder {
    static constexpr bool PAIRED = true;
    int nM, nN, G, c, dpa, dpb; int latent_only = 0;
    __device__ __forceinline__ bool next(int i, Unit& u) const {
        const int j = i >> 1, seg = i & 1; int pm, pn; if (!tile_order((long)j * G + c, nM, nN, pm, pn)) return false;
        if (latent_only) pm += (pm >> 5) + 1;
        u.pa = pm + seg * dpa; u.pb = pn + seg * dpb; u.pm = pm; u.pn = pn; return true;
    }
};

template <class Epi, class Sched, bool ALIGN_EPI, bool SP2>
__device__ __forceinline__ void gemm_phase(LAS unsigned char* lds, const Gemm g, const Sched& S, const Epi& E, const int tid) {
    const int wid = __builtin_amdgcn_readfirstlane(tid >> 6), lane = tid & 63, wr = wid >> 2, wc = wid & 3, fr = lane & 15, fq = lane >> 4;
    const int K = g.K, nt = K / BK;
    unsigned voffA[2], voffB[2];
#pragma unroll
    for (int i = 0; i < 2; ++i) { int R, C; stage_rc(tid * 16 + i * 8192, R, C); const int Rb = Epi::PERM ? ((R & ~31) + perm32(R & 31)) : R;
        voffA[i] = (unsigned)(R * g.lda + C) * 2u; voffB[i] = (unsigned)(Rb * g.ldb + C) * 2u; }
    const size_t kstep = (size_t)(BK * 2);
    const size_t hstepA = (size_t)HALF * g.lda * 2, hstepB = (size_t)HALF * g.ldb * 2;
    const size_t tstepA = 2 * hstepA, tstepB = 2 * hstepB;
    const unsigned ldsw = (unsigned)wid * 1024u;
    const int aoff = lds_byte(wr * 64 + fr, fq * 8), boff = lds_byte(wc * 32 + fr, fq * 8);
#define PG8_SA(b, h) (((b) * 2 + (h)) * HTB)
#define PG8_SB(b, h) ((4 + (b) * 2 + (h)) * HTB)
#define PG8_STAGE(bufoff, gbase, voff) do { _Pragma("unroll") for (int _i = 0; _i < 2; ++_i) \
        __builtin_amdgcn_global_load_lds((const unsigned*)((const char*)(gbase) + (voff)[_i]), (LAS unsigned*)(lds + (bufoff) + ldsw + _i * 8192), 16, 0, 0); } while (0)
#define PG8_LDA(dst, b, h) do { _Pragma("unroll") for (int m = 0; m < 4; ++m) _Pragma("unroll") for (int k = 0; k < 2; ++k) dst[m][k] = *(const LAS bf16x8*)(lds + PG8_SA(b, h) + aoff + m * 2048 + k * 1024); } while (0)
#define PG8_LDB(dst, b, h) do { _Pragma("unroll") for (int n = 0; n < 2; ++n) _Pragma("unroll") for (int k = 0; k < 2; ++k) dst[n][k] = *(const LAS bf16x8*)(lds + PG8_SB(b, h) + boff + n * 2048 + k * 1024); } while (0)
#define PG8_MMA(ai, bj, At, Bt) do { __builtin_amdgcn_s_setprio(1); _Pragma("unroll") for (int m = 0; m < 4; ++m) _Pragma("unroll") for (int n = 0; n < 2; ++n) _Pragma("unroll") for (int k = 0; k < 2; ++k) \
        acc[ai][bj][m][n] = __builtin_amdgcn_mfma_f32_16x16x32_bf16(Bt[n][k], At[m][k], acc[ai][bj][m][n], 0, 0, 0); __builtin_amdgcn_s_setprio(0); } while (0)
#define PG8_WAIT_V(n) asm volatile("s_waitcnt vmcnt(" #n ")" ::: "memory")
#define PG8_WAIT_L(n) asm volatile("s_waitcnt lgkmcnt(" #n ")" ::: "memory")
#define PG8_BAR __builtin_amdgcn_s_barrier()
#define PG8_SCHED __builtin_amdgcn_sched_barrier(0)
    Unit cur, nxt; int ui = 0;
    if (!S.next(0, cur)) return;
    f32x4 acc[2][2][4][2];
#pragma unroll
    for (int a = 0; a < 2; ++a)
#pragma unroll
        for (int b = 0; b < 2; ++b)
#pragma unroll
            for (int m = 0; m < 4; ++m)
#pragma unroll
                for (int n = 0; n < 2; ++n) acc[a][b][m][n] = (f32x4){0.f, 0.f, 0.f, 0.f};
    bf16x8 At[4][2], B0[2][2], B1[2][2];
    const char* cA = (const char*)g.A + (size_t)cur.pa * tstepA; const char* cB = (const char*)g.Bt + (size_t)cur.pb * tstepB;
    if constexpr (SP2) {
        PG8_STAGE(PG8_SB(0, 0), cB, voffB); PG8_STAGE(PG8_SB(0, 1), cB + hstepB, voffB); PG8_STAGE(PG8_SA(0, 0), cA, voffA); PG8_STAGE(PG8_SA(0, 1), cA + hstepA, voffA);
        if (wr == 1) PG8_BAR;
        PG8_WAIT_V(2); PG8_BAR;
        PG8_STAGE(PG8_SB(1, 0), cB + kstep, voffB); PG8_STAGE(PG8_SA(1, 0), cA + kstep, voffA); PG8_STAGE(PG8_SB(1, 1), cB + hstepB + kstep, voffB);
        PG8_WAIT_V(6); PG8_BAR;
    } else {
        PG8_STAGE(PG8_SB(0, 0), cB, voffB); PG8_STAGE(PG8_SA(0, 0), cA, voffA); PG8_STAGE(PG8_SB(0, 1), cB + hstepB, voffB); PG8_STAGE(PG8_SA(0, 1), cA + hstepA, voffA);
        if (wr == 1) PG8_BAR;
        PG8_WAIT_V(4); PG8_BAR;
        PG8_STAGE(PG8_SB(1, 0), cB + kstep, voffB); PG8_STAGE(PG8_SA(1, 0), cA + kstep, voffA); PG8_STAGE(PG8_SB(1, 1), cB + hstepB + kstep, voffB);
        PG8_WAIT_V(6); PG8_BAR;
    }
    for (;;) {
        const bool has_next = S.next(ui + 1, nxt);
        const char* nA = has_next ? (const char*)g.A + (size_t)nxt.pa * tstepA : cA; const char* nB = has_next ? (const char*)g.Bt + (size_t)nxt.pb * tstepB : cB;
#pragma clang loop unroll(disable)
        for (int t = 0; t < nt; t += 2) {
            const bool last = (t == nt - 2);
            const char* a1 = cA + (size_t)(t + 1) * kstep;
            const char* a2 = last ? nA : cA + (size_t)(t + 2) * kstep; const char* b2 = last ? nB : cB + (size_t)(t + 2) * kstep;
            const char* a3 = a2 + kstep; const char* b3 = b2 + kstep;
            if constexpr (SP2) {
            PG8_LDB(B0, 0, 0); PG8_LDB(B1, 0, 1); PG8_SCHED; PG8_LDA(At, 0, 0); PG8_STAGE(PG8_SA(1, 1), a1 + hstepA, voffA);
            PG8_WAIT_V(8); PG8_WAIT_L(0); PG8_BAR; PG8_MMA(0, 0, At, B0); PG8_MMA(0, 1, At, B1); PG8_BAR; PG8_SCHED;
            PG8_LDA(At, 0, 1); PG8_STAGE(PG8_SB(0, 0), b2, voffB); PG8_STAGE(PG8_SB(0, 1), b2 + hstepB, voffB); PG8_STAGE(PG8_SA(0, 0), a2, voffA);
            PG8_WAIT_V(8); PG8_WAIT_L(0); PG8_BAR; PG8_MMA(1, 0, At, B0); PG8_MMA(1, 1, At, B1); PG8_BAR; PG8_SCHED;
            PG8_LDB(B0, 1, 0); PG8_LDB(B1, 1, 1); PG8_SCHED; PG8_LDA(At, 1, 0); PG8_STAGE(PG8_SA(0, 1), a2 + hstepA, voffA);
            PG8_WAIT_V(8); PG8_WAIT_L(0); PG8_BAR; PG8_MMA(0, 0, At, B0); PG8_MMA(0, 1, At, B1); PG8_BAR; PG8_SCHED;
            PG8_LDA(At, 1, 1); PG8_STAGE(PG8_SB(1, 0), b3, voffB); PG8_STAGE(PG8_SB(1, 1), b3 + hstepB, voffB); PG8_STAGE(PG8_SA(1, 0), a3, voffA);
            PG8_WAIT_V(8); PG8_WAIT_L(0); PG8_BAR; PG8_MMA(1, 0, At, B0); PG8_MMA(1, 1, At, B1); PG8_BAR; PG8_SCHED;
            } else {
            PG8_LDB(B0, 0, 0); PG8_SCHED; PG8_LDA(At, 0, 0); PG8_STAGE(PG8_SA(1, 1), a1 + hstepA, voffA);
            PG8_WAIT_L(8); PG8_BAR; PG8_WAIT_L(0); PG8_MMA(0, 0, At, B0); PG8_BAR; PG8_SCHED;
            PG8_LDB(B1, 0, 1); PG8_STAGE(PG8_SB(0, 0), b2, voffB);
            PG8_BAR; PG8_WAIT_L(0); PG8_MMA(0, 1, At, B1); PG8_BAR;
            PG8_LDA(At, 0, 1); PG8_STAGE(PG8_SA(0, 0), a2, voffA);
            PG8_BAR; PG8_WAIT_L(0); PG8_MMA(1, 0, At, B0); PG8_BAR; PG8_SCHED;
            PG8_STAGE(PG8_SB(0, 1), b2 + hstepB, voffB);
            PG8_WAIT_V(6); PG8_BAR; PG8_MMA(1, 1, At, B1); PG8_BAR;
            PG8_LDB(B0, 1, 0); PG8_SCHED; PG8_LDA(At, 1, 0); PG8_STAGE(PG8_SA(0, 1), a2 + hstepA, voffA);
            PG8_WAIT_L(8); PG8_BAR; PG8_WAIT_L(0); PG8_MMA(0, 0, At, B0); PG8_BAR; PG8_SCHED;
            PG8_LDB(B1, 1, 1); PG8_STAGE(PG8_SB(1, 0), b3, voffB);
            PG8_BAR; PG8_WAIT_L(0); PG8_MMA(0, 1, At, B1); PG8_BAR;
            PG8_LDA(At, 1, 1); PG8_STAGE(PG8_SA(1, 0), a3, voffA);
            PG8_BAR; PG8_WAIT_L(0); PG8_MMA(1, 0, At, B0); PG8_BAR; PG8_SCHED;
            PG8_STAGE(PG8_SB(1, 1), b3 + hstepB, voffB);
            PG8_WAIT_V(6); PG8_BAR; PG8_MMA(1, 1, At, B1); PG8_BAR;
            }
        }
        if constexpr (ALIGN_EPI) { if (wr == 0) PG8_BAR; }
        bool fin = true;
        if constexpr (Sched::PAIRED) { fin = (cur.pa != cur.pm); if (fin) E(acc, cur, wr, wc, fr, fq); else E.mid(acc, cur, wr, wc, fr, fq); }
        else E(acc, cur, wr, wc, fr, fq);
        if (!has_next) break;
        if (fin) {
#pragma unroll
        for (int a = 0; a < 2; ++a)
#pragma unroll
            for (int b = 0; b < 2; ++b)
#pragma unroll
                for (int m = 0; m < 4; ++m)
#pragma unroll
                    for (int n = 0; n < 2; ++n) acc[a][b][m][n] = (f32x4){0.f, 0.f, 0.f, 0.f};
        }
        cur = nxt; cA = nA; cB = nB; ++ui;
        if constexpr (ALIGN_EPI) { if (wr == 1) PG8_BAR; }
    }
    PG8_WAIT_V(0);
    if constexpr (!ALIGN_EPI) { if (wr == 0) PG8_BAR; }
    PG8_BAR;
#undef PG8_SA
#undef PG8_SB
#undef PG8_STAGE
#undef PG8_LDA
#undef PG8_LDB
#undef PG8_MMA
#undef PG8_WAIT_V
#undef PG8_WAIT_L
#undef PG8_BAR
#undef PG8_SCHED
}

__device__ __forceinline__ u32x4 pack8(const f32x4 v0, const f32x4 v1) {
    u32x4 w; w.x = cvt_pk_bf16(v0[0], v0[1]); w.y = cvt_pk_bf16(v0[2], v0[3]); w.z = cvt_pk_bf16(v1[0], v1[1]); w.w = cvt_pk_bf16(v1[2], v1[3]); return w;
}
struct EpiBf16 {
    static constexpr bool PERM = true;
    bf16_t* O; int ldc; int sig_from; int prow_off;
    __device__ __forceinline__ void operator()(const f32x4 (&acc)[2][2][4][2], const Unit& u, int wr, int wc, int fr, int fq) const {
        const int row0 = (u.pm - prow_off) * BM + wr * 64 + fr, col0 = u.pn * BM + wc * 32 + 8 * fq;
#pragma unroll
        for (int ai = 0; ai < 2; ++ai)
#pragma unroll
            for (int m = 0; m < 4; ++m) { bf16_t* rowp = O + (size_t)(row0 + ai * HALF + m * 16) * ldc + col0;
#pragma unroll
                for (int bj = 0; bj < 2; ++bj) { f32x4 v0 = acc[ai][bj][m][0], v1 = acc[ai][bj][m][1];
                    if (col0 + bj * HALF >= sig_from) {
#pragma unroll
                        for (int q = 0; q < 4; ++q) { v0[q] = fast_sigmoid(v0[q]); v1[q] = fast_sigmoid(v1[q]); } }
                    *(u32x4*)(rowp + bj * HALF) = pack8(v0, v1); } }
    }
};
struct EpiIn {
    static constexpr bool PERM = true;
    bf16_t* O; float* ssq_q; float* ssq_kv; bf16_t* Km; const float* rope_m; const float* rope_g; const float* gq; const float* gk;
    __device__ __forceinline__ void operator()(const f32x4 (&acc)[2][2][4][2], const Unit& u, int wr, int wc, int fr, int fq) const {
        const int row0 = u.pm * BM + wr * 64 + fr, col0 = u.pn * BM + wc * 32 + 8 * fq;
        const int tp = u.pm % PPB; const bool rot = tp != 0;
        const bool isq = u.pn < 5, ishead = (u.pn == 3) || (u.pn == 4) || (u.pn == 5 && wc < 2), isv = (u.pn == 5 && wc >= 2), gate = u.pn >= 6, kpe = (u.pn == 2 && wc == 0);
        int cb0 = col0, cb1 = col0 + HALF;
        if (ishead) { const int head = isq ? 4 * (u.pn - 3) + wc : wc; cb0 = (isq ? C_QG : C_KG) + head * 64 + 8 * fq; cb1 = cb0 + 32; }
        if (isv) { cb0 = C_VG + (wc - 2) * 64 + 8 * fq; cb1 = cb0 + 32; }
        const float* gg = (isq ? gq : gk) + 8 * fq; const float qs = isq ? 0.125f * LOG2E : 1.0f;
        const int f0 = (fq & 1) * 8; const bool up = (fq & 2) != 0;
#pragma unroll
        for (int ai = 0; ai < 2; ++ai)
#pragma unroll
            for (int m = 0; m < 4; ++m) { const int row = row0 + ai * HALF + m * 16; bf16_t* rowp = O + (size_t)row * DINP;
                f32x4 v[2][2] = {{acc[ai][0][m][0], acc[ai][0][m][1]}, {acc[ai][1][m][0], acc[ai][1][m][1]}};
                const int grow = (tp - 1) * 4 + 2 * ai + wr, gcol = 16 * m + fr;
                if (u.pn < 3) {
                    float sq[2];
#pragma unroll
                    for (int bj = 0; bj < 2; ++bj) { const f32x4 a = v[bj][0], b = v[bj][1];
                        float t = (a[0] * a[0] + a[1] * a[1]) + (a[2] * a[2] + a[3] * a[3]) + (b[0] * b[0] + b[1] * b[1]) + (b[2] * b[2] + b[3] * b[3]);
                        t += lane_xor<16>(t); { auto rr = __builtin_amdgcn_permlane32_swap(__float_as_uint(t), __float_as_uint(t), false, false); t = __uint_as_float(rr[0]) + __uint_as_float(rr[1]); }
                        sq[bj] = t; }
                    if (fq == 0) {
                        if (u.pn == 0) ssq_q[(size_t)row * 8 + wc] = sq[0] + sq[1];
                        else if (u.pn == 1) { ssq_q[(size_t)row * 8 + 4 + wc] = sq[0]; ssq_kv[(size_t)row * 8 + wc] = sq[1]; }
                        else ssq_kv[(size_t)row * 8 + 4 + wc] = sq[0]; }
                    if (kpe) {
                        const int pos = (fq < 2) ? grow : gcol;
                        f32x4 c0 = (f32x4){1.f, 1.f, 1.f, 1.f}, c1 = c0, s0 = (f32x4){0.f, 0.f, 0.f, 0.f}, s1 = s0;
                        if (rot) { const f32x4* rp = (const f32x4*)(rope_m + pos * 16); c0 = rp[0]; c1 = rp[1]; s0 = rp[2]; s1 = rp[3]; }
                        if (!(fq & 1)) { s0 = -s0; s1 = -s1; }
                        f32x4 p0, p1;
#pragma unroll
                        for (int q = 0; q < 4; ++q) { p0[q] = lane_xor<16>(v[1][0][q]); p1[q] = lane_xor<16>(v[1][1][q]); }
                        const u32x4 ow = pack8(v[1][0] * c0 + p0 * s0, v[1][1] * c1 + p1 * s1);
#pragma unroll
                        for (int h = 0; h < 8; ++h) *(u32x4*)(Km + (size_t)row * 768 + h * 96 + 64 + 8 * fq) = ow; }
                }
                if (ishead) {
                    float ss = 0.f;
#pragma unroll
                    for (int bj = 0; bj < 2; ++bj)
#pragma unroll
                        for (int n = 0; n < 2; ++n) { const f32x4 x = v[bj][n]; ss += (x[0] * x[0] + x[1] * x[1]) + (x[2] * x[2] + x[3] * x[3]); }
                    ss += lane_xor<16>(ss); { auto rr = __builtin_amdgcn_permlane32_swap(__float_as_uint(ss), __float_as_uint(ss), false, false); ss = __uint_as_float(rr[0]) + __uint_as_float(rr[1]); }
                    const float rstd = 1.0f / sqrtf(ss * (1.0f / 64.0f) + EPS);
#pragma unroll
                    for (int bj = 0; bj < 2; ++bj) {
                        const f32x4 g0 = *(const f32x4*)(gg + 32 * bj), g1 = *(const f32x4*)(gg + 32 * bj + 4);
                        const f32x4 y0 = v[bj][0] * rstd * g0, y1 = v[bj][1] * rstd * g1;
                        f32x4 c0 = (f32x4){1.f, 1.f, 1.f, 1.f}, c1 = c0, s0 = (f32x4){0.f, 0.f, 0.f, 0.f}, s1 = s0;
                        if (rot) { const f32x4* rp = (const f32x4*)(rope_g + (bj ? gcol : grow) * 32 + f0); c0 = rp[0]; c1 = rp[1]; s0 = rp[4]; s1 = rp[5]; }
                        if (!up) { s0 = -s0; s1 = -s1; }
                        f32x4 p0, p1;
#pragma unroll
                        for (int q = 0; q < 4; ++q) {
                            { auto rr = __builtin_amdgcn_permlane32_swap(__float_as_uint(y0[q]), __float_as_uint(y0[q]), false, false); p0[q] = __uint_as_float(up ? rr[0] : rr[1]); }
                            { auto rr = __builtin_amdgcn_permlane32_swap(__float_as_uint(y1[q]), __float_as_uint(y1[q]), false, false); p1[q] = __uint_as_float(up ? rr[0] : rr[1]); } }
                        v[bj][0] = (y0 * c0 + p0 * s0) * qs; v[bj][1] = (y1 * c1 + p1 * s1) * qs; }
                }
                if (gate) {
#pragma unroll
                    for (int bj = 0; bj < 2; ++bj)
#pragma unroll
                        for (int q = 0; q < 4; ++q) { v[bj][0][q] = fast_sigmoid(v[bj][0][q]); v[bj][1][q] = fast_sigmoid(v[bj][1][q]); } }
                *(u32x4*)(rowp + cb0) = pack8(v[0][0], v[0][1]);
                *(u32x4*)(rowp + cb1) = pack8(v[1][0], v[1][1]);
            }
    }
};
struct EpiQ {
    static constexpr bool PERM = true; static constexpr float QSC = 0.10206207261596575f * LOG2E;
    bf16_t* Qm; const float* rope; const float* ssq;
    __device__ __forceinline__ float rstd_of(size_t row) const { const f32x4 a = *(const f32x4*)(ssq + row * 8), b = *(const f32x4*)(ssq + row * 8 + 4);
        return 1.0f / sqrtf(((a[0] + a[1]) + (a[2] + a[3]) + (b[0] + b[1]) + (b[2] + b[3])) * (1.0f / 384.0f) + EPS); }
    __device__ __forceinline__ void operator()(const f32x4 (&acc)[2][2][4][2], const Unit& u, int wr, int wc, int fr, int fq) const {
        const int row0 = u.pm * BM + wr * 64 + fr;
        if (u.pn < 2) {
#pragma unroll
            for (int bj = 0; bj < 2; ++bj) { const int c = u.pn * BM + bj * HALF + wc * 32 + 8 * fq, h = c >> 6, d = c & 63;
#pragma unroll
                for (int ai = 0; ai < 2; ++ai)
#pragma unroll
                    for (int m = 0; m < 4; ++m) { const size_t row = (size_t)(row0 + ai * HALF + m * 16); const float sc = QSC * rstd_of(row);
                        *(u32x4*)(Qm + row * 768 + h * 96 + d) = pack8(acc[ai][bj][m][0] * sc, acc[ai][bj][m][1] * sc); } }
        } else {
            const int tp = u.pm % PPB; const bool rot = tp != 0;
#pragma unroll
            for (int ai = 0; ai < 2; ++ai)
#pragma unroll
                for (int m = 0; m < 4; ++m) {
                    const int grow = (tp - 1) * 4 + 2 * ai + wr, gcol = 16 * m + fr, pos = (fq < 2) ? grow : gcol;
                    f32x4 c0 = (f32x4){1.f, 1.f, 1.f, 1.f}, c1 = c0, s0 = (f32x4){0.f, 0.f, 0.f, 0.f}, s1 = s0;
                    if (rot) { const f32x4* rp = (const f32x4*)(rope + pos * 16); c0 = rp[0]; c1 = rp[1]; s0 = rp[2]; s1 = rp[3]; }
                    const float sc = QSC * rstd_of((size_t)(row0 + ai * HALF + m * 16));
                    if (!(fq & 1)) { s0 = -s0; s1 = -s1; }
#pragma unroll
                    for (int bj = 0; bj < 2; ++bj) { const int h = 4 * bj + wc;
                        const f32x4 v0 = acc[ai][bj][m][0], v1 = acc[ai][bj][m][1]; f32x4 p0, p1;
#pragma unroll
                        for (int q = 0; q < 4; ++q) { p0[q] = lane_xor<16>(v0[q]); p1[q] = lane_xor<16>(v1[q]); }
                        const f32x4 o0 = (v0 * c0 + p0 * s0) * sc, o1 = (v1 * c1 + p1 * s1) * sc;
                        *(u32x4*)(Qm + (size_t)(row0 + ai * HALF + m * 16) * 768 + h * 96 + 64 + 8 * fq) = pack8(o0, o1); }
                    asm volatile("" ::: "memory"); __builtin_amdgcn_sched_barrier(0);
                }
        }
    }
};
struct EpiKV {
    static constexpr bool PERM = true;
    bf16_t* Km; bf16_t* Vm; const float* ssq;
    __device__ __forceinline__ void operator()(const f32x4 (&acc)[2][2][4][2], const Unit& u, int wr, int wc, int fr, int fq) const {
        const int row0 = u.pm * BM + wr * 64 + fr;
#pragma unroll
        for (int bj = 0; bj < 2; ++bj) { const int h = 2 * u.pn + bj, j = wc * 32 + 8 * fq;
            bf16_t* base = (j < 64) ? Km + h * 96 + j : Vm + h * 64 + (j - 64); const int ld = (j < 64) ? 768 : 512;
#pragma unroll
            for (int ai = 0; ai < 2; ++ai)
#pragma unroll
                for (int m = 0; m < 4; ++m) { const size_t row = (size_t)(row0 + ai * HALF + m * 16);
                    const f32x4 a = *(const f32x4*)(ssq + row * 8), b = *(const f32x4*)(ssq + row * 8 + 4);
                    const float sc = 1.0f / sqrtf(((a[0] + a[1]) + (a[2] + a[3]) + (b[0] + b[1]) + (b[2] + b[3])) * (1.0f / 256.0f) + EPS);
                    *(u32x4*)(base + row * ld) = pack8(acc[ai][bj][m][0] * sc, acc[ai][bj][m][1] * sc); } }
    }
};
struct EpiGate2 {
    static constexpr bool PERM = true;
    bf16_t* MG; const bf16_t* gm; const bf16_t* gg;
    __device__ __forceinline__ void mid(f32x4 (&acc)[2][2][4][2], const Unit& u, int wr, int wc, int fr, int fq) const {
        const int row0 = u.pm * BM + wr * 64 + fr, col0 = u.pn * BM + wc * 32 + 8 * fq;
#pragma unroll
        for (int ai = 0; ai < 2; ++ai)
#pragma unroll
            for (int m = 0; m < 4; ++m) { const size_t row = (size_t)(row0 + ai * HALF + m * 16);
#pragma unroll
                for (int bj = 0; bj < 2; ++bj) { const int c = col0 + bj * HALF;
                    const u32x4 a = *(const u32x4*)(gm + row * DINP + c), b = *(const u32x4*)(gg + row * DINP + c);
                    f32x4& v0 = acc[ai][bj][m][0]; f32x4& v1 = acc[ai][bj][m][1];
                    v0[0] *= bflo(a.x) * __builtin_amdgcn_rcpf(fmaxf(bflo(b.x), 1e-30f)); v0[1] *= bfhi(a.x) * __builtin_amdgcn_rcpf(fmaxf(bfhi(b.x), 1e-30f));
                    v0[2] *= bflo(a.y) * __builtin_amdgcn_rcpf(fmaxf(bflo(b.y), 1e-30f)); v0[3] *= bfhi(a.y) * __builtin_amdgcn_rcpf(fmaxf(bfhi(b.y), 1e-30f));
                    v1[0] *= bflo(a.z) * __builtin_amdgcn_rcpf(fmaxf(bflo(b.z), 1e-30f)); v1[1] *= bfhi(a.z) * __builtin_amdgcn_rcpf(fmaxf(bfhi(b.z), 1e-30f));
                    v1[2] *= bflo(a.w) * __builtin_amdgcn_rcpf(fmaxf(bflo(b.w), 1e-30f)); v1[3] *= bfhi(a.w) * __builtin_amdgcn_rcpf(fmaxf(bfhi(b.w), 1e-30f)); } }
    }
    __device__ __forceinline__ void operator()(const f32x4 (&acc)[2][2][4][2], const Unit& u, int wr, int wc, int fr, int fq) const {
        const int row0 = u.pm * BM + wr * 64 + fr, col0 = u.pn * BM + wc * 32 + 8 * fq;
#pragma unroll
        for (int ai = 0; ai < 2; ++ai)
#pragma unroll
            for (int m = 0; m < 4; ++m) { const size_t row = (size_t)(row0 + ai * HALF + m * 16);
#pragma unroll
                for (int bj = 0; bj < 2; ++bj) { const int c = col0 + bj * HALF;
                    const u32x4 gw = *(const u32x4*)(gg + row * DINP + c);
                    f32x4 v0 = acc[ai][bj][m][0], v1 = acc[ai][bj][m][1];
                    v0[0] *= bflo(gw.x); v0[1] *= bfhi(gw.x); v0[2] *= bflo(gw.y); v0[3] *= bfhi(gw.y);
                    v1[0] *= bflo(gw.z); v1[1] *= bfhi(gw.z); v1[2] *= bflo(gw.w); v1[3] *= bfhi(gw.w);
                    *(u32x4*)(MG + row * D + c) = pack8(v0, v1); } }
    }
};
template <bool ACCUM> struct EpiGate {
    static constexpr bool PERM = true;
    bf16_t* MG; const bf16_t* gate;
    __device__ __forceinline__ void operator()(const f32x4 (&acc)[2][2][4][2], const Unit& u, int wr, int wc, int fr, int fq) const {
        const int row0 = u.pm * BM + wr * 64 + fr, col0 = u.pn * BM + wc * 32 + 8 * fq;
#pragma unroll
        for (int ai = 0; ai < 2; ++ai)
#pragma unroll
            for (int m = 0; m < 4; ++m) { const size_t row = (size_t)(row0 + ai * HALF + m * 16);
#pragma unroll
                for (int bj = 0; bj < 2; ++bj) { const int c = col0 + bj * HALF;
                    const u32x4 gw = *(const u32x4*)(gate + row * DINP + c);
                    f32x4 v0 = acc[ai][bj][m][0], v1 = acc[ai][bj][m][1];
                    v0[0] *= bflo(gw.x); v0[1] *= bfhi(gw.x); v0[2] *= bflo(gw.y); v0[3] *= bfhi(gw.y);
                    v1[0] *= bflo(gw.z); v1[1] *= bfhi(gw.z); v1[2] *= bflo(gw.w); v1[3] *= bfhi(gw.w);
                    if (ACCUM) { const u32x4 ow = *(const u32x4*)(MG + row * D + c);
                        v0[0] += bflo(ow.x); v0[1] += bfhi(ow.x); v0[2] += bflo(ow.y); v0[3] += bfhi(ow.y);
                        v1[0] += bflo(ow.z); v1[1] += bfhi(ow.z); v1[2] += bflo(ow.w); v1[3] += bfhi(ow.w); }
                    *(u32x4*)(MG + row * D + c) = pack8(v0, v1); } }
    }
};
struct EpiRes {
    static constexpr bool PERM = true;
    bf16_t* XR; const float* modv;
    __device__ __forceinline__ void operator()(const f32x4 (&acc)[2][2][4][2], const Unit& u, int wr, int wc, int fr, int fq) const {
        const int row0 = u.pm * BM + wr * 64 + fr, col0 = u.pn * BM + wc * 32 + 8 * fq;
        const int tp = u.pm % PPB, v = tp == 0 ? 4 : u.pm / PPB; const float* gp = modv + (size_t)v * 6 * D + col0;
        f32x4 gv[2][2];
#pragma unroll
        for (int bj = 0; bj < 2; ++bj)
#pragma unroll
            for (int n = 0; n < 2; ++n) gv[bj][n] = *(const f32x4*)(gp + bj * HALF + n * 4);
#pragma unroll
        for (int ai = 0; ai < 2; ++ai)
#pragma unroll
            for (int m = 0; m < 4; ++m) { bf16_t* rowp = XR + (size_t)(row0 + ai * HALF + m * 16) * D + col0;
#pragma unroll
                for (int bj = 0; bj < 2; ++bj) { u32x4* p = (u32x4*)(rowp + bj * HALF); const u32x4 w = *p;
                    const f32x4 v0 = bf4((u32x2){w.x, w.y}) + gv[bj][0] * acc[ai][bj][m][0], v1 = bf4((u32x2){w.z, w.w}) + gv[bj][1] * acc[ai][bj][m][1];
                    *p = pack8(v0, v1); } }
    }
};
struct EpiSwiglu {
    static constexpr bool PERM = true;
    bf16_t* HH; int ldc; int prow_off;
    __device__ __forceinline__ void operator()(const f32x4 (&acc)[2][2][4][2], const Unit& u, int wr, int wc, int fr, int fq) const {
        const int row0 = (u.pm - prow_off) * BM + wr * 64 + fr, col0 = u.pn * HALF + wc * 32 + 8 * fq;
#pragma unroll
        for (int ai = 0; ai < 2; ++ai)
#pragma unroll
            for (int m = 0; m < 4; ++m) { f32x4 o[2];
#pragma unroll
                for (int n = 0; n < 2; ++n)
#pragma unroll
                    for (int q = 0; q < 4; ++q) { const float a1 = acc[ai][0][m][n][q], a3 = acc[ai][1][m][n][q]; o[n][q] = a1 * fast_sigmoid(a1) * a3; }
                *(u32x4*)(HH + (size_t)(row0 + ai * HALF + m * 16) * ldc + col0) = pack8(o[0], o[1]); }
    }
};
}

namespace att {
constexpr int NW = 8, QBLK = 32, KVBLK = 64;
__device__ __forceinline__ int crow(int r, int hi) { return (r & 3) + 8 * (r >> 2) + 4 * hi; }
#define SBAR() __builtin_amdgcn_sched_barrier(0)
template <int DK> struct Cfg { static constexpr int KSTR = DK * 2 + 16, KB = KVBLK * KSTR, VB = KVBLK * 64 * 2, NQ = DK / 16, NKL = DK / 64 + (DK % 64 ? 1 : 0);
    static constexpr int OFF_V = 0, OFF_K = 2 * VB, OFF_WS = 2 * VB + 2 * KB, BYTES = OFF_WS + NW * 64 * 4; };

__device__ __forceinline__ void partialSM(f32x16& p0, f32x16& p1, float& m_reg, float& alpha, float C, float thr_raw) {
    float pmax = p0[0];
#pragma unroll
    for (int r = 1; r < 16; ++r) pmax = fmaxf(pmax, p0[r]);
#pragma unroll
    for (int r = 0; r < 16; ++r) pmax = fmaxf(pmax, p1[r]);
    { auto rr = __builtin_amdgcn_permlane32_swap(__float_as_uint(pmax), __float_as_uint(pmax), false, false);
      pmax = fmaxf(__uint_as_float(rr[0]), __uint_as_float(rr[1])); }
    float mn;
    if (__builtin_expect(__all(pmax - m_reg <= thr_raw), 1)) { mn = m_reg; alpha = 1.f; }
    else { mn = fmaxf(m_reg, pmax); alpha = __builtin_amdgcn_exp2f((m_reg - mn) * C); m_reg = mn; }
    const float mnC = -mn * C;
#pragma unroll
    for (int r = 0; r < 16; ++r) p0[r] = fmaf(p0[r], C, mnC);
#pragma unroll
    for (int r = 0; r < 16; ++r) p1[r] = fmaf(p1[r], C, mnC);
#pragma unroll
    for (int r = 0; r < 16; ++r) p0[r] = __builtin_amdgcn_exp2f(p0[r]);
}
__device__ __forceinline__ void finishSM(f32x16& p0, f32x16& p1, float alpha, float& l_reg, bf16x8& pa0, bf16x8& pa1, bf16x8& pa2, bf16x8& pa3) {
#pragma unroll
    for (int r = 0; r < 16; ++r) p1[r] = __builtin_amdgcn_exp2f(p1[r]);
    float ps = 0;
#pragma unroll
    for (int r = 0; r < 16; ++r) ps += p0[r];
#pragma unroll
    for (int r = 0; r < 16; ++r) ps += p1[r];
    { auto rr = __builtin_amdgcn_permlane32_swap(__float_as_uint(ps), __float_as_uint(ps), false, false);
      ps = __uint_as_float(rr[0]) + __uint_as_float(rr[1]); }
    l_reg = l_reg * alpha + ps;
#define PK4(P, BASE, OUT) do { unsigned a0 = cvt_pk_bf16(P[BASE + 0], P[BASE + 1]), a1 = cvt_pk_bf16(P[BASE + 2], P[BASE + 3]);   \
    unsigned b0 = cvt_pk_bf16(P[BASE + 4], P[BASE + 5]), b1 = cvt_pk_bf16(P[BASE + 6], P[BASE + 7]);                              \
    auto r0 = __builtin_amdgcn_permlane32_swap(a0, b0, false, false); auto r1 = __builtin_amdgcn_permlane32_swap(a1, b1, false, false); \
    u32x4 w = {r0[0], r1[0], r0[1], r1[1]}; OUT = __builtin_bit_cast(bf16x8, w); } while (0)
    PK4(p0, 0, pa0); PK4(p0, 8, pa1); PK4(p1, 0, pa2); PK4(p1, 8, pa3);
#undef PK4
}
template <int DK> __device__ __forceinline__ void qkt(f32x16& p0, f32x16& p1, const LAS char* Ks, const bf16x8* qr, int r32, int hi) {
    p0 = f32x16{}; p1 = f32x16{};
    const LAS char* k0 = Ks + r32 * Cfg<DK>::KSTR + hi * 16;
#pragma unroll
    for (int d0 = 0; d0 < Cfg<DK>::NQ; ++d0) {
        const bf16x8 b0 = *(const LAS bf16x8*)(k0 + d0 * 32);
        const bf16x8 b1 = *(const LAS bf16x8*)(k0 + 32 * Cfg<DK>::KSTR + d0 * 32);
        p0 = __builtin_amdgcn_mfma_f32_32x32x16_bf16(b0, qr[d0], p0, 0, 0, 0);
        p1 = __builtin_amdgcn_mfma_f32_32x32x16_bf16(b1, qr[d0], p1, 0, 0, 0); }
}
__device__ __forceinline__ int v_st(int k, int c) { const int kk = (k & ~0xC) | ((k & 4) << 1) | ((k & 8) >> 1); return ((kk >> 3) * 2 + (c >> 5)) * 512 + ((kk & 7) * 32 + (c & 31)) * 2; }
__device__ __forceinline__ int v_rd_base(int lane) { return ((lane & 3) << 3) | (((lane >> 2) & 3) << 6) | (((lane >> 4) & 1) << 5) | (((lane >> 5) & 1) << 8); }
constexpr int v_rd_off(int d0, int ks, int half) { return d0 * 512 + ks * 2048 + half * 1024; }
template <int OFF> __device__ __forceinline__ s16x4 tr_read(int vb) {
    s16x4 r; asm volatile("ds_read_b64_tr_b16 %0, %1 offset:%2" : "=&v"(r) : "v"(vb), "i"(OFF) : "memory"); return r;
}
template <int D0> __device__ __forceinline__ void pv_one(f32x16& od, int vb, bf16x8 pa0, bf16x8 pa1, bf16x8 pa2, bf16x8 pa3) {
    const s16x4 l0 = tr_read<v_rd_off(D0, 0, 0)>(vb), h0 = tr_read<v_rd_off(D0, 0, 1)>(vb), l1 = tr_read<v_rd_off(D0, 1, 0)>(vb), h1 = tr_read<v_rd_off(D0, 1, 1)>(vb);
    const s16x4 l2 = tr_read<v_rd_off(D0, 2, 0)>(vb), h2 = tr_read<v_rd_off(D0, 2, 1)>(vb), l3 = tr_read<v_rd_off(D0, 3, 0)>(vb), h3 = tr_read<v_rd_off(D0, 3, 1)>(vb);
    asm volatile("s_waitcnt lgkmcnt(0)" ::: "memory"); SBAR();
#define PK(L, H) (bf16x8){L[0], L[1], L[2], L[3], H[0], H[1], H[2], H[3]}
    od = __builtin_amdgcn_mfma_f32_32x32x16_bf16(pa0, PK(l0, h0), od, 0, 0, 0);
    od = __builtin_amdgcn_mfma_f32_32x32x16_bf16(pa1, PK(l1, h1), od, 0, 0, 0);
    od = __builtin_amdgcn_mfma_f32_32x32x16_bf16(pa2, PK(l2, h2), od, 0, 0, 0);
    od = __builtin_amdgcn_mfma_f32_32x32x16_bf16(pa3, PK(l3, h3), od, 0, 0, 0);
#undef PK
}
__device__ __forceinline__ void pv_all(f32x16* o, int vb, bf16x8 pa0, bf16x8 pa1, bf16x8 pa2, bf16x8 pa3) {
    pv_one<0>(o[0], vb, pa0, pa1, pa2, pa3); pv_one<1>(o[1], vb, pa0, pa1, pa2, pa3);
}

template <int DK>
__device__ __forceinline__ void attn_unit(const bf16_t* __restrict__ Qb, int ldq, const bf16_t* __restrict__ Kh, int ldk, const bf16_t* __restrict__ Vh, int ldv,
                                          bf16_t* __restrict__ Ob, int ldo, int NT, float C, float thr_raw, LAS char* lds, const int tid) {
    using CF = Cfg<DK>;
    const int wid = tid >> 6, lane = tid & 63, r32 = lane & 31, hi = lane >> 5;
    LAS char* V_lds = lds + CF::OFF_V; LAS char* K_lds = lds + CF::OFF_K;
    LAS float* ws = (LAS float*)(lds + CF::OFF_WS) + wid * 64; LAS float* li_l = ws; LAS float* al_l = ws + 32;
    float m_reg = -1e30f, l_reg = 0; f32x16 o[2] = {}; bf16x8 qr[CF::NQ];
    const bf16_t* Qw = Qb + (size_t)(wid * QBLK + r32) * ldq + hi * 8;
#pragma unroll
    for (int d0 = 0; d0 < CF::NQ; ++d0) qr[d0] = *(const bf16x8*)(Qw + d0 * 16);
    constexpr int CPR = DK / 8;
    const int vrow = tid >> 3, vcol = (tid & 7) * 8, vst = v_st(vrow, vcol);
    const int kid0 = tid, kid1 = 512 + (tid & 255);
    const int kr0 = kid0 / CPR, kc0 = kid0 % CPR, kr1 = kid1 / CPR, kc1 = kid1 % CPR;
    const int kst0 = kr0 * CF::KSTR + kc0 * 16, kst1 = kr1 * CF::KSTR + kc1 * 16;
    const int vb0 = (int)(uintptr_t)V_lds + v_rd_base(lane);
    bf16x8 sv[2], sk0[2], sk1[2];
#define SLOAD(i, k0) do { sv[i] = *(const bf16x8*)(Vh + (size_t)((k0) + vrow) * ldv + vcol); \
    sk0[i] = *(const bf16x8*)(Kh + (size_t)((k0) + kr0) * ldk + kc0 * 8); \
    if (DK == 96) sk1[i] = *(const bf16x8*)(Kh + (size_t)((k0) + kr1) * ldk + kc1 * 8); } while (0)
#define SWRITE(b, i) do { *(LAS bf16x8*)(V_lds + (b) * CF::VB + vst) = sv[i]; *(LAS bf16x8*)(K_lds + (b) * CF::KB + kst0) = sk0[i]; \
    if (DK == 96) *(LAS bf16x8*)(K_lds + (b) * CF::KB + kst1) = sk1[i]; } while (0)
#define SWAIT() do { if (DK == 96) asm volatile("s_waitcnt vmcnt(3)" ::: "memory"); else asm volatile("s_waitcnt vmcnt(2)" ::: "memory"); } while (0)
#define RESC(a) do { if (__any((a) < 1.f)) { if (hi == 0) al_l[r32] = (a); asm volatile("s_waitcnt lgkmcnt(0)" ::: "memory"); \
    _Pragma("unroll") for (int d = 0; d < 2; ++d) _Pragma("unroll") for (int r = 0; r < 16; ++r) o[d][r] *= al_l[crow(r, hi)]; } } while (0)
    f32x16 pA0, pA1, pB0, pB1; float alA, alB; bf16x8 pa0, pa1, pa2, pa3;
    __syncthreads();
    SLOAD(0, 0); asm volatile("s_waitcnt vmcnt(0)" ::: "memory"); SWRITE(0, 0); __syncthreads();
    qkt<DK>(pA0, pA1, K_lds, qr, r32, hi); partialSM(pA0, pA1, m_reg, alA, C, thr_raw);
    SLOAD(1, KVBLK); if (2 < NT) SLOAD(0, 2 * KVBLK);
    SWAIT(); SWRITE(1, 1); __syncthreads();
    for (int j = 1; j + 1 < NT; j += 2) {
        SBAR(); qkt<DK>(pB0, pB1, K_lds + CF::KB, qr, r32, hi);
        finishSM(pA0, pA1, alA, l_reg, pa0, pa1, pa2, pa3); SBAR();
        SLOAD(1, (j + 2) * KVBLK); SBAR();
        pv_all(o, vb0, pa0, pa1, pa2, pa3); partialSM(pB0, pB1, m_reg, alB, C, thr_raw);
        __syncthreads(); SWAIT(); SWRITE(0, 0);
        RESC(alB); __syncthreads();
        SBAR(); qkt<DK>(pA0, pA1, K_lds, qr, r32, hi);
        finishSM(pB0, pB1, alB, l_reg, pa0, pa1, pa2, pa3); SBAR();
        if (j + 3 < NT) SLOAD(0, (j + 3) * KVBLK); SBAR();
        pv_all(o, vb0 + CF::VB, pa0, pa1, pa2, pa3); partialSM(pA0, pA1, m_reg, alA, C, thr_raw);
        __syncthreads(); SWAIT(); SWRITE(1, 1);
        RESC(alA); __syncthreads();
    }
    SBAR(); qkt<DK>(pB0, pB1, K_lds + CF::KB, qr, r32, hi);
    finishSM(pA0, pA1, alA, l_reg, pa0, pa1, pa2, pa3); SBAR();
    pv_all(o, vb0, pa0, pa1, pa2, pa3); partialSM(pB0, pB1, m_reg, alB, C, thr_raw);
    __syncthreads(); RESC(alB);
    finishSM(pB0, pB1, alB, l_reg, pa0, pa1, pa2, pa3); SBAR();
    pv_all(o, vb0 + CF::VB, pa0, pa1, pa2, pa3);
    if (hi == 0) li_l[r32] = l_reg; asm volatile("s_waitcnt lgkmcnt(0)" ::: "memory");
    float rli[16];
#pragma unroll
    for (int r = 0; r < 16; ++r) rli[r] = __builtin_amdgcn_rcpf(li_l[crow(r, hi)]);
    bf16_t* Ow = Ob + (size_t)(wid * QBLK) * ldo;
#pragma unroll
    for (int r = 0; r < 16; ++r) { const int orow = crow(r, hi);
#pragma unroll
        for (int d0 = 0; d0 < 2; ++d0) Ow[(size_t)orow * ldo + d0 * 32 + r32] = (bf16_t)(cvt_pk_bf16(o[d0][r] * rli[r], 0.f) & 0xffffu); }
#undef SLOAD
#undef SWRITE
#undef SWAIT
#undef RESC
}
#undef SBAR
}


namespace att2 {
constexpr int NW = 8, QBLK = 32, KVBLK = 64, NSLOT = 3, VSLOTB = 8192;
template <int DK> struct LL { static constexpr int NQ = DK / 16, KSLOTB = DK * 128, LDS_K = 0, LDS_V = NSLOT * KSLOTB, LDS_WS = LDS_V + NSLOT * VSLOTB, LDS_OST = LDS_WS + NW * 64 * 4, BYTES = LDS_OST + NW * 4096; };
__device__ __forceinline__ int crow(int r, int hi) { return (r & 3) + 8 * (r >> 2) + 4 * hi; }
#define SBAR() __builtin_amdgcn_sched_barrier(0)
__device__ __forceinline__ void glds16(const void* gsrc, unsigned lds_dst) { unsigned keep;
    asm volatile("s_mov_b32 %0, m0\n\ts_mov_b32 m0, %2\n\ts_nop 0\n\tglobal_load_lds_dwordx4 %1, off\n\ts_mov_b32 m0, %0" : "=&s"(keep) : "v"(gsrc), "s"(lds_dst) : "memory"); }
typedef __bf16 bf16x2_t __attribute__((ext_vector_type(2)));
__device__ __forceinline__ unsigned cvtpk_s(float lo, float hi) { f32x2 v = {lo, hi}; bf16x2_t b = __builtin_convertvector(v, bf16x2_t); return __builtin_bit_cast(unsigned, b); }
#define WAIT_BAR(N) asm volatile("s_waitcnt vmcnt(" #N ") lgkmcnt(0)\n\ts_barrier" ::: "memory")
typedef LAS const char* lds_cptr;
typedef short v4i16_t __attribute__((ext_vector_type(4)));
__device__ __forceinline__ void kload2(bf16x8* kf, lds_cptr kp, int j) { kf[2 * j] = *(const LAS bf16x8*)(kp + j * 2048); kf[2 * j + 1] = *(const LAS bf16x8*)(kp + j * 2048 + 512); }
__device__ __forceinline__ s16x4 vtr(lds_cptr p) { return __builtin_bit_cast(s16x4, __builtin_amdgcn_ds_read_tr16_b64_v4i16((LAS v4i16_t*)p)); }

template <int DK>
__device__ __forceinline__ bool attn_unit(const bf16_t* Qb, int ldq, const bf16_t* __restrict__ Kh, int ldk, const bf16_t* __restrict__ Vh, int ldv, bf16_t* Ob, int ldo, int NT, LAS char* shm, int tid) {
    using L = LL<DK>; constexpr int NQ = L::NQ, KSLOTB = L::KSLOTB;
    const int lane = tid & 63, r32 = lane & 31, hi = lane >> 5; const int wid = __builtin_amdgcn_readfirstlane(tid >> 6);
    const bf16_t* Qw = Qb + (long)(wid * QBLK) * ldq;
    const unsigned lds0 = (unsigned)(uintptr_t)shm;
    LAS float* wsf = (LAS float*)(shm + L::LDS_WS) + wid * 64;
    const bf16_t* ksrc = Kh + (long)lane * ldk + wid * 8;
    const bf16_t* ksrc2 = Kh + (long)((wid & 1) * 32 + r32) * ldk + 64 + (wid >> 1) * 8;
    const bf16_t* vsrc = Vh + (long)(16 * (wid & 3) + (lane >> 2)) * ldv + (wid >> 2) * 32 + (lane & 3) * 8;
    const unsigned kdst = lds0 + L::LDS_K + wid * 1024, kdst2 = lds0 + L::LDS_K + (8 + (wid >> 1)) * 1024 + (wid & 1) * 512, vdst = lds0 + L::LDS_V + wid * 1024;
#define DMA_K(t, ks) do { glds16(ksrc + (long)(t) * KVBLK * ldk, (unsigned)__builtin_amdgcn_readfirstlane(kdst + (ks))); \
        if (DK == 96) { if (hi == 0) glds16(ksrc2 + (long)(t) * KVBLK * ldk, (unsigned)__builtin_amdgcn_readfirstlane(kdst2 + (ks))); } } while (0)
#define DMA_V(t, vs) glds16(vsrc + (long)(t) * KVBLK * ldv, (unsigned)__builtin_amdgcn_readfirstlane(vdst + (vs)))
#define WAIT_NV() do { if (DK == 96) WAIT_BAR(3); else WAIT_BAR(2); } while (0)
    const lds_cptr shm3 = (lds_cptr)shm; const lds_cptr kp0 = shm3 + L::LDS_K + hi * 1024 + r32 * 16;
    const lds_cptr vp0 = shm3 + L::LDS_V + ((lane >> 4) & 1) * 32 + (lane & 3) * 8 + (4 * hi + ((lane & 15) >> 2)) * 64;
    bf16x8 kf[2 * NQ];
    DMA_K(0, 0); DMA_V(0, 0); DMA_K(1, KSLOTB);
    bf16x8 qr[NQ];
#pragma unroll
    for (int d0 = 0; d0 < NQ; ++d0) qr[d0] = *(const bf16x8*)(Qw + (long)r32 * ldq + d0 * 16 + hi * 8);
    float l_reg = 0.f; f32x16 o[2]; o[0] = f32x16{}; o[1] = f32x16{};
    f32x16 pA0, pA1, pB0, pB1;
    int ks_prev = 0, ks_cur = 0, ks_next = KSLOTB, vs_prev = 0, vs_cur = 0, vs_next = VSLOTB;
#define ROT() do { ks_prev = ks_cur; ks_cur = ks_next; ks_next = (ks_next == (NSLOT - 1) * KSLOTB) ? 0 : ks_next + KSLOTB; \
                   vs_prev = vs_cur; vs_cur = vs_next; vs_next = (vs_next == (NSLOT - 1) * VSLOTB) ? 0 : vs_next + VSLOTB; } while (0)
    DMA_K(2, 2 * KSLOTB);
    if (DK == 96) WAIT_BAR(5); else WAIT_BAR(3);
    { pA0 = f32x16{}; pA1 = f32x16{};
#pragma unroll
      for (int d0 = 0; d0 < NQ; ++d0) { const bf16x8 b0 = *(const LAS bf16x8*)(kp0 + d0 * 2048), b1 = *(const LAS bf16x8*)(kp0 + d0 * 2048 + 512);
          pA0 = __builtin_amdgcn_mfma_f32_32x32x16_bf16(b0, qr[d0], pA0, 0, 0, 0); pA1 = __builtin_amdgcn_mfma_f32_32x32x16_bf16(b1, qr[d0], pA1, 0, 0, 0); }
#pragma unroll
      for (int r = 0; r < 16; ++r) pA0[r] = __builtin_amdgcn_exp2f(pA0[r]);
#pragma unroll
      for (int r = 0; r < 16; ++r) pA1[r] = __builtin_amdgcn_exp2f(pA1[r]); }
    WAIT_BAR(0);
    DMA_K(3, 0); DMA_V(1, VSLOTB);
    ROT();
#pragma unroll
    for (int j = 0; j < NQ; ++j) kload2(kf, kp0 + ks_cur, j);
    WAIT_NV();
    s16x4 vlo[8], vhi[8]; u32x4 pw0, pw1, pw2, pw3;
#define PKW(P, B) cvtpk_s(P[B], P[B + 1])
#define PAF(k) __builtin_bit_cast(bf16x8, pw##k)
#define VFR(i) (bf16x8){vlo[i][0], vlo[i][1], vlo[i][2], vlo[i][3], vhi[i][0], vhi[i][1], vhi[i][2], vhi[i][3]}
#define PIN(x) asm volatile("" : "+v"(x))
#define GAPA(MF, A0, A1, A2, A3, W0, W1, PW) do { MF; sacc += A0; sacc += A1; sacc += A2; sacc += A3; PIN(sacc); W0; W1; PIN(PW); SBAR(); } while (0)
#define EX(v) __builtin_amdgcn_exp2f(v)
#define GAPB(MF, X, B) do { MF; X[B] = EX(X[B]); X[B + 1] = EX(X[B + 1]); X[B + 2] = EX(X[B + 2]); X[B + 3] = EX(X[B + 3]); PIN(X); SBAR(); } while (0)
#define VRD(i) do { vlo[i] = vtr(vp_ + (((i) >> 2) * 4096 + ((i) & 3) * 1024)); vhi[i] = vtr(vp_ + (((i) >> 2) * 4096 + ((i) & 3) * 1024 + 512)); } while (0)
#define KRD(G, j) do { if (G) { kload2(kf, kp0 + ks_next, j); SBAR(); } } while (0)
#define MF32 __builtin_amdgcn_mfma_f32_32x32x16_bf16
    const f32x16 Z16 = f32x16{};
#define STEP(C0, C1, P0, P1, t, GK, GV, GL) do { SBAR(); \
    const lds_cptr vp_ = vp0 + vs_prev; \
    VRD(0); SBAR(); float sacc = (P0[0] + P0[1]); \
    GAPA(C0 = MF32(kf[0], qr[0], Z16, 0, 0, 0), P0[2], P0[3], P0[4], P0[5],     pw0[0] = PKW(P0, 0), pw0[1] = PKW(P0, 2), pw0); \
    VRD(4); SBAR(); GAPA(C1 = MF32(kf[1], qr[0], Z16, 0, 0, 0), P0[6], P0[7], P0[8], P0[9],     pw0[2] = PKW(P0, 4), pw0[3] = PKW(P0, 6), pw0); \
    VRD(1); SBAR(); GAPA(C0 = MF32(kf[2], qr[1], C0, 0, 0, 0),   P0[10], P0[11], P0[12], P0[13], pw1[0] = PKW(P0, 8), pw1[1] = PKW(P0, 10), pw1); \
    VRD(5); SBAR(); GAPA(C1 = MF32(kf[3], qr[1], C1, 0, 0, 0),   P0[14], P0[15], P1[0], P1[1],   pw1[2] = PKW(P0, 12), pw1[3] = PKW(P0, 14), pw1); \
    VRD(2); SBAR(); GAPA(C0 = MF32(kf[4], qr[2], C0, 0, 0, 0),   P1[2], P1[3], P1[4], P1[5],     pw2[0] = PKW(P1, 0), pw2[1] = PKW(P1, 2), pw2); \
    VRD(6); SBAR(); GAPA(C1 = MF32(kf[5], qr[2], C1, 0, 0, 0),   P1[6], P1[7], P1[8], P1[9],     pw2[2] = PKW(P1, 4), pw2[3] = PKW(P1, 6), pw2); \
    VRD(3); SBAR(); GAPA(C0 = MF32(kf[6], qr[3], C0, 0, 0, 0),   P1[10], P1[11], P1[12], P1[13], pw3[0] = PKW(P1, 8), pw3[1] = PKW(P1, 10), pw3); \
    VRD(7); SBAR(); GAPA(C1 = MF32(kf[7], qr[3], C1, 0, 0, 0),   P1[14], P1[15], 0.f, 0.f,       pw3[2] = PKW(P1, 12), pw3[3] = PKW(P1, 14), pw3); \
    if constexpr (DK == 96) { C0 = MF32(kf[8], qr[4], C0, 0, 0, 0); C1 = MF32(kf[9], qr[4], C1, 0, 0, 0); C0 = MF32(kf[10], qr[5], C0, 0, 0, 0); C1 = MF32(kf[11], qr[5], C1, 0, 0, 0); SBAR(); } \
    l_reg += sacc; \
    if (GK) { DMA_K((t) + 3, ks_cur); } if (GV) { DMA_V((t) + 1, vs_next); } \
    SBAR(); \
    GAPB(o[0] = MF32(PAF(0), VFR(0), o[0], 0, 0, 0), C0, 0); \
    GAPB(o[1] = MF32(PAF(0), VFR(4), o[1], 0, 0, 0), C0, 4); \
    KRD(GL, 0); GAPB(o[0] = MF32(PAF(1), VFR(1), o[0], 0, 0, 0), C0, 8); \
    KRD(GL, 1); GAPB(o[1] = MF32(PAF(1), VFR(5), o[1], 0, 0, 0), C0, 12); \
    KRD(GL, 2); GAPB(o[0] = MF32(PAF(2), VFR(2), o[0], 0, 0, 0), C1, 0); \
    KRD(GL, 3); GAPB(o[1] = MF32(PAF(2), VFR(6), o[1], 0, 0, 0), C1, 4); \
    if constexpr (DK == 96) { KRD(GL, 4); } GAPB(o[0] = MF32(PAF(3), VFR(3), o[0], 0, 0, 0), C1, 8); \
    if constexpr (DK == 96) { KRD(GL, 5); } GAPB(o[1] = MF32(PAF(3), VFR(7), o[1], 0, 0, 0), C1, 12); \
    } while (0)
    int t = 1;
    for (; t + 5 < NT; t += 2) {
        STEP(pB0, pB1, pA0, pA1, t, true, true, true);     WAIT_NV(); ROT();
        STEP(pA0, pA1, pB0, pB1, t + 1, true, true, true); WAIT_NV(); ROT();
    }
#define ENDW(tt) do { if ((tt) + 3 < NT) { WAIT_NV(); } else if ((tt) + 2 < NT) { WAIT_BAR(1); } else { WAIT_BAR(0); } } while (0)
    for (; t + 1 < NT; t += 2) {
        STEP(pB0, pB1, pA0, pA1, t, (t + 3 < NT), (t + 1 < NT), (t + 1 < NT));       ENDW(t);     ROT();
        STEP(pA0, pA1, pB0, pB1, t + 1, (t + 4 < NT), (t + 2 < NT), (t + 2 < NT));   ENDW(t + 1); ROT();
    }
    STEP(pB0, pB1, pA0, pA1, NT - 1, false, false, false);
    { float sacc = pB0[0] + pB0[1];
#pragma unroll
      for (int r = 2; r < 16; ++r) sacc += pB0[r];
#pragma unroll
      for (int r = 0; r < 16; ++r) sacc += pB1[r];
      l_reg += sacc;
      pw0 = (u32x4){PKW(pB0, 0), PKW(pB0, 2), PKW(pB0, 4), PKW(pB0, 6)}; pw1 = (u32x4){PKW(pB0, 8), PKW(pB0, 10), PKW(pB0, 12), PKW(pB0, 14)};
      pw2 = (u32x4){PKW(pB1, 0), PKW(pB1, 2), PKW(pB1, 4), PKW(pB1, 6)}; pw3 = (u32x4){PKW(pB1, 8), PKW(pB1, 10), PKW(pB1, 12), PKW(pB1, 14)};
      SBAR();
      const lds_cptr vp_ = vp0 + vs_cur;
#pragma unroll
      for (int i = 0; i < 8; ++i) VRD(i);
      o[0] = MF32(PAF(0), VFR(0), o[0], 0, 0, 0); o[0] = MF32(PAF(1), VFR(1), o[0], 0, 0, 0); o[0] = MF32(PAF(2), VFR(2), o[0], 0, 0, 0); o[0] = MF32(PAF(3), VFR(3), o[0], 0, 0, 0);
      o[1] = MF32(PAF(0), VFR(4), o[1], 0, 0, 0); o[1] = MF32(PAF(1), VFR(5), o[1], 0, 0, 0); o[1] = MF32(PAF(2), VFR(6), o[1], 0, 0, 0); o[1] = MF32(PAF(3), VFR(7), o[1], 0, 0, 0); }
    { auto rr = __builtin_amdgcn_permlane32_swap(__float_as_uint(l_reg), __float_as_uint(l_reg), false, false); l_reg = __uint_as_float(rr[0]) + __uint_as_float(rr[1]); }
    const bool bad = __any(!(l_reg > 1e-30f && l_reg < 1e30f));
    if (hi == 0) wsf[32 + r32] = l_reg; asm volatile("s_waitcnt lgkmcnt(0)" ::: "memory");
    float rli[16];
#pragma unroll
    for (int r = 0; r < 16; ++r) rli[r] = __builtin_amdgcn_rcpf(wsf[32 + crow(r, hi)]);
    bf16_t* Ow = Ob + (long)(wid * QBLK) * ldo;
    { LAS bf16_t* stg = (LAS bf16_t*)(shm + L::LDS_OST) + wid * 2048;
#pragma unroll
      for (int r = 0; r < 16; ++r) { const int orow = crow(r, hi);
#pragma unroll
          for (int d0 = 0; d0 < 2; ++d0) stg[orow * 64 + d0 * 32 + r32] = (bf16_t)(cvtpk_s(o[d0][r] * rli[r], 0.f) & 0xffffu); }
      asm volatile("s_waitcnt lgkmcnt(0)" ::: "memory");
#pragma unroll
      for (int i = 0; i < 4; ++i) { const int row = i * 8 + (lane >> 3), ch = lane & 7; const u32x4 v = *(const LAS u32x4*)(stg + row * 64 + ch * 8); *(u32x4*)(Ow + (long)row * ldo + ch * 8) = v; } }
    return bad;
#undef DMA_K
#undef DMA_V
#undef WAIT_NV
#undef ROT
#undef PKW
#undef PAF
#undef VFR
#undef PIN
#undef GAPA
#undef EX
#undef GAPB
#undef VRD
#undef KRD
#undef MF32
#undef STEP
#undef ENDW
}
#undef SBAR
#undef WAIT_BAR
}

#define XB_TMO      128
#define XB_XCNT(j)  (256  + 64 * (j))
#define XB_XSUB(j)  (1280 + 64 * (j))
#define XB_XGEN(j)  (2304 + 64 * (j))
#define XB_TOP      3328
#define XB_TOPGEN   3392
#define XCD_BAR_WORDS 3456
#define XB_SPIN_CAP (1u << 24)
__device__ __forceinline__ unsigned xb_ld(unsigned* p)              { return __hip_atomic_load(p, __ATOMIC_RELAXED, __HIP_MEMORY_SCOPE_AGENT); }
__device__ __forceinline__ unsigned xb_add(unsigned* p, unsigned v) { return __hip_atomic_fetch_add(p, v, __ATOMIC_RELAXED, __HIP_MEMORY_SCOPE_AGENT); }
__device__ __forceinline__ unsigned xb_xcc_id() { return (unsigned)__builtin_amdgcn_s_getreg((3 << 11) | 20) & 0xFu; }
#define XB_SPIN(cond, bar) do { unsigned _sp = 0; while (cond) { __builtin_amdgcn_s_sleep(1); \
    if ((++_sp & 255u) == 0u) { if (xb_ld(&(bar)[XB_TMO])) break; if (_sp > XB_SPIN_CAP) { atomicAdd(&(bar)[XB_TMO], 1u); break; } } } } while (0)
struct XcdBarrier { unsigned* bar; unsigned x; volatile LAS unsigned* st; };
__device__ __forceinline__ XcdBarrier xcd_barrier_post(unsigned* bar, volatile LAS unsigned* st) {
    XcdBarrier b; b.bar = bar; b.x = xb_xcc_id(); b.st = st;
    if (threadIdx.x == 0) (void)xb_add(&bar[XB_XCNT(b.x)], 1u);
    return b;
}
__device__ __forceinline__ void xcd_barrier_complete(unsigned* bar, unsigned x, unsigned& nloc, unsigned& nx) {
    const unsigned G = gridDim.x * gridDim.y * gridDim.z;
    unsigned sum, cnt, mine, sp = 0u;
    for (;;) {
        sum = 0u; cnt = 0u; mine = 0u;
#pragma unroll
        for (unsigned j = 0; j < 16; ++j) { const unsigned c = xb_ld(&bar[XB_XCNT(j)]); sum += c; cnt += (c > 0u) ? 1u : 0u; mine = (j == x) ? c : mine; }
        if (sum == G) break;
        __builtin_amdgcn_s_sleep(1);
        if ((++sp & 255u) == 0u) { if (xb_ld(&bar[XB_TMO])) break; if (sp > XB_SPIN_CAP) { atomicAdd(&bar[XB_TMO], 1u); break; } }
    }
    nloc = mine > 0u ? mine : 1u; nx = cnt > 0u ? cnt : 1u;
}
__device__ __forceinline__ void xcd_barrier(const XcdBarrier& b) {
    asm volatile("s_waitcnt vmcnt(0)" ::: "memory");
    __syncthreads();
    if (threadIdx.x == 0) {
        unsigned* bar = b.bar;
        __builtin_amdgcn_s_waitcnt(0);
        unsigned nloc = b.st[0], nx = b.st[1];
        if (nloc == 0u) { xcd_barrier_complete(bar, b.x, nloc, nx); b.st[0] = nloc; b.st[1] = nx; }
        const unsigned old = xb_add(&bar[XB_XSUB(b.x)], 1u);
        const unsigned gen = old / nloc;
        if (old + 1u == (gen + 1u) * nloc) {
            __builtin_amdgcn_fence(__ATOMIC_RELEASE, "agent");
            asm volatile("s_waitcnt vmcnt(0)" ::: "memory");
            const unsigned og = xb_add(&bar[XB_TOP], 1u);
            const unsigned tg = og / nx;
            if (og + 1u == (tg + 1u) * nx) xb_add(&bar[XB_TOPGEN], 1u);
            else XB_SPIN(xb_ld(&bar[XB_TOPGEN]) == tg, bar);
            __builtin_amdgcn_fence(__ATOMIC_ACQUIRE, "agent");
            xb_add(&bar[XB_XGEN(b.x)], 1u);
            asm volatile("s_waitcnt vmcnt(0)" ::: "memory");
        } else {
            XB_SPIN(xb_ld(&bar[XB_XGEN(b.x)]) == gen, bar);
            __builtin_amdgcn_fence(__ATOMIC_ACQUIRE, "agent");
            asm volatile("s_waitcnt vmcnt(0)" ::: "memory");
        }
    }
    __syncthreads();
}

struct Args {
    const float* in[26];
    float* out;
    unsigned char* ws;
    int ph_lo, ph_hi;
    float inv_mla[8];
    float inv_gqa[16];
};
enum { IN_X = 0, IN_C, IN_CTX, IN_CCTX, IN_WADA, IN_BADA, IN_N1G, IN_N2G, IN_WIN, IN_QNG, IN_WQB, IN_KVNG, IN_WKVB, IN_GQG, IN_GKG, IN_WOM, IN_WOG, IN_WOUT,
       IN_DW1, IN_DW3, IN_DW2, IN_ROUTER, IN_MW1, IN_MW3, IN_MW2, IN_FNG };

struct Ctx { int lane, wave, gw, NGW, vcu, G; LAS unsigned char* lds; };

__device__ __forceinline__ void cvt_item(const float* src, int ldw, bf16_t* dst, int K, int k0, LAS float* scr, int lane, const float* kg = nullptr) {
    if (src) {
#pragma unroll 8
        for (int i = 0; i < 32; ++i) { const int kk = 2 * i + (lane >> 5); const float gk = kg ? kg[k0 + kk] : 1.0f; scr[kk * 33 + (lane & 31)] = src[(size_t)(k0 + kk) * ldw + (lane & 31)] * gk; }
    }
    asm volatile("s_waitcnt vmcnt(0) lgkmcnt(0)" ::: "memory");
    const int c = lane & 7;
#pragma unroll
    for (int j = 0; j < 4; ++j) { const int n = (lane >> 3) + 8 * j; const LAS float* s = scr + (8 * c) * 33 + n;
        u32x4 o = (u32x4){0u, 0u, 0u, 0u};
        if (src) { o.x = cvt_pk_bf16(s[0 * 33], s[1 * 33]); o.y = cvt_pk_bf16(s[2 * 33], s[3 * 33]); o.z = cvt_pk_bf16(s[4 * 33], s[5 * 33]); o.w = cvt_pk_bf16(s[6 * 33], s[7 * 33]); }
        *(u32x4*)(dst + (size_t)n * K + k0 + 8 * c) = o; }
    asm volatile("s_waitcnt lgkmcnt(0)" ::: "memory");
}
template <int KIND>
__device__ __forceinline__ void cvt_job(const Ctx& X, int& base, int ngroups, int K, bf16_t* dst, const float* p0, const float* p1, int ldw, int gmax, const float* kg = nullptr) {
    const int nkb = K / 64, nitems = ngroups * nkb;
    LAS float* scr = (LAS float*)(X.lds + X.wave * 8448);
    int first = X.gw - (base % X.NGW); if (first < 0) first += X.NGW;
    for (int it = first; it < nitems; it += X.NGW) {
        const int g = it / nkb, kb = it % nkb; const float* src;
        if (KIND == 0) { src = p0 + g * 32; if (g >= gmax) src = nullptr; }
        else if (KIND == 1) { const int pn = g >> 3, j = g & 7; const size_t off = (size_t)pn * 128 + (j & 3) * 32; const size_t d = (j >> 2) ? (size_t)(p1 - p0) : 0; src = p0 + d + off; }
        else if (KIND == 2) { src = g < 16 ? p0 + (g >> 1) * 96 + (g & 1) * 32 : p0 + (g - 16) * 96 + 64; }
        else {
            if (g < 21) src = p0 + g * 32;
            else if (g < 24) src = nullptr;
            else if (g < 40) { const int t = (g - 24) >> 3, j = (g - 24) & 7; src = p0 + 672 + (4 * t + (j & 3)) * 64 + 32 * (j >> 2); }
            else if (g < 48) { const int j = g - 40, wc = j & 3, bj = j >> 2; src = wc < 2 ? p0 + 1184 + wc * 64 + 32 * bj : p0 + 1312 + (wc - 2) * 64 + 32 * bj; }
            else src = p0 + 1440 + (g - 48) * 32; }
        cvt_item(src, ldw, dst + (size_t)g * 32 * K, K, kb * 64, scr, X.lane, kg);
    }
    base += nitems;
}
__device__ __forceinline__ void cvt_moe_layer(const Ctx& X, int& base, const float* mw1, const float* mw3, const float* mw2, unsigned char* ws, int li) {
    bf16_t* w13 = (bf16_t*)(ws + WS_WMOE13); bf16_t* w2 = (bf16_t*)(ws + WS_WMOE2);
    for (int e = 0; e < NE; ++e) {
        const float* w1 = mw1 + (size_t)(li * NE + e) * D * FE; const float* w3 = mw3 + (size_t)(li * NE + e) * D * FE;
        cvt_job<1>(X, base, 2 * FE / 32, D, w13 + (size_t)e * 2 * FE * D, w1, w3, FE, 1 << 30);
        const float* w2s = mw2 + (size_t)(li * NE + e) * FE * D;
        cvt_job<0>(X, base, D / 32, FE, w2 + (size_t)e * D * FE, w2s, w2s, D, 1 << 30);
    }
}
__device__ __forceinline__ void sincos_d(float ang, float& c, float& s) {
    const double a = (double)ang; const double k = __builtin_rint(a * 0.63661977236758134308); const long n = (long)k;
    const double r = (a - k * 1.57079632673412561417e+00) - k * 6.07710050650619224932e-11;
    const double r2 = r * r;
    double sp = -7.6471637318198164759e-13; sp = sp * r2 + 1.6059043836821614599e-10; sp = sp * r2 - 2.5052108385441718775e-08; sp = sp * r2 + 2.7557319223985890653e-06;
    sp = sp * r2 - 1.9841269841269841270e-04; sp = sp * r2 + 8.3333333333333333333e-03; sp = sp * r2 - 1.6666666666666666667e-01; const double sr = r + r * r2 * sp;
    double cp = 4.7794773323873852974e-14; cp = cp * r2 - 1.1470745597729724714e-11; cp = cp * r2 + 2.0876756987868098979e-09; cp = cp * r2 - 2.7557319223985890653e-07;
    cp = cp * r2 + 2.4801587301587301587e-05; cp = cp * r2 - 1.3888888888888888889e-03; cp = cp * r2 + 4.1666666666666666667e-02; const double cr = 1.0 - 0.5 * r2 + r2 * r2 * cp;
    const int q = (int)(n & 3);
    const double sv = (q == 0) ? sr : (q == 1) ? cr : (q == 2) ? -sr : -cr;
    const double cv = (q == 0) ? cr : (q == 1) ? -sr : (q == 2) ? -cr : sr;
    c = (float)cv; s = (float)sv;
}


__device__ __forceinline__ void lds_fill(LAS unsigned char* dst, const float* src, int n4, int tid) {
    for (int i = tid; i < n4; i += 512) ((LAS f32x4*)dst)[i] = ((const f32x4*)src)[i];
}
constexpr int TL_GAIN = 0, TL_MOD = 4096, TL_G2 = 4096 + 40960, TL_ROUTER = 65536, TL_ROPEM = 98304, TL_ROPEG = 106496;

template <bool FIRST, bool COMBINE>
__device__ __forceinline__ void norm1_rows(const Ctx& X, int l, bf16_t* XR, bf16_t* Hb, const bf16_t* Yg, const float* modp, const i32x2* tok_slot, const f32x2* tok_w,
                                           const float* gain, const float* xin, const float* cin, int tid) {
    const int lane = X.lane; const float* modl = modp + (size_t)l * 5 * 6 * D;
    lds_fill(X.lds + TL_GAIN, gain, D / 4, tid);
    for (int v = 0; v < 5; ++v) { lds_fill(X.lds + TL_MOD + v * 8192, modl + (size_t)v * 6 * D, 2 * D / 4, tid);
        if (COMBINE) lds_fill(X.lds + TL_G2 + v * 4096, modp + ((size_t)((l - 1) * 5 + v) * 6 + 5) * D, D / 4, tid); }
    __syncthreads();
    auto src_of = [&](int row) -> const float* { const int b = row / TPB, t = row - b * TPB;
        return t < NCTX ? cin + ((size_t)b * NCTX + t) * D : xin + ((size_t)b * SEQ + (t - NCTX)) * D; };
    f32x4 xnf[4]; u32x2 xnb[4]; i32x2 sln = (i32x2){0, 0}; f32x2 wn = (f32x2){0.f, 0.f};
    { const int row0 = X.gw < T ? X.gw : T - 1;
      if (FIRST) { const float* src = src_of(row0);
#pragma unroll
          for (int j = 0; j < 4; ++j) xnf[j] = ((const f32x4*)src)[lane + 64 * j]; }
      else {
#pragma unroll
          for (int j = 0; j < 4; ++j) xnb[j] = ((const u32x2*)(XR + (size_t)row0 * D))[lane + 64 * j]; }
      if (COMBINE) { sln = tok_slot[row0]; wn = tok_w[row0]; } }
    for (int row = X.gw; row < T; row += X.NGW) {
        const int b = row / TPB, t = row - b * TPB, v = t < NCTX ? 4 : b;
        f32x4 x[4]; const i32x2 sl = sln; const f32x2 w = wn;
#pragma unroll
        for (int j = 0; j < 4; ++j) x[j] = FIRST ? xnf[j] : bf4(xnb[j]);
        u32x2 ya[4], yb[4];
        if (COMBINE) {
#pragma unroll
            for (int j = 0; j < 4; ++j) { ya[j] = ((const u32x2*)(Yg + (size_t)sl.x * D))[lane + 64 * j]; yb[j] = ((const u32x2*)(Yg + (size_t)sl.y * D))[lane + 64 * j]; } }
        { const int nrow = row + X.NGW; if (nrow < T) {
            if (FIRST) { const float* src = src_of(nrow);
#pragma unroll
                for (int j = 0; j < 4; ++j) xnf[j] = ((const f32x4*)src)[lane + 64 * j]; }
            else {
#pragma unroll
                for (int j = 0; j < 4; ++j) xnb[j] = ((const u32x2*)(XR + (size_t)nrow * D))[lane + 64 * j]; }
            if (COMBINE) { sln = tok_slot[nrow]; wn = tok_w[nrow]; } } }
        if (COMBINE) { const LAS f32x4* g2 = (const LAS f32x4*)(X.lds + TL_G2 + v * 4096);
#pragma unroll
            for (int j = 0; j < 4; ++j) { const f32x4 g = g2[lane + 64 * j];
                x[j][0] += g[0] * (w.x * bflo(ya[j].x) + w.y * bflo(yb[j].x)); x[j][1] += g[1] * (w.x * bfhi(ya[j].x) + w.y * bfhi(yb[j].x));
                x[j][2] += g[2] * (w.x * bflo(ya[j].y) + w.y * bflo(yb[j].y)); x[j][3] += g[3] * (w.x * bfhi(ya[j].y) + w.y * bfhi(yb[j].y)); } }
        if (FIRST || COMBINE) {
#pragma unroll
            for (int j = 0; j < 4; ++j) { u32x2 o; o.x = cvt_pk_bf16(x[j][0], x[j][1]); o.y = cvt_pk_bf16(x[j][2], x[j][3]); ((u32x2*)(XR + (size_t)row * D))[lane + 64 * j] = o; } }
        float ss = 0.f;
#pragma unroll
        for (int j = 0; j < 4; ++j) ss += (x[j][0] * x[j][0] + x[j][1] * x[j][1]) + (x[j][2] * x[j][2] + x[j][3] * x[j][3]);
        const float rstd = 1.0f / sqrtf(wave_sum(ss) * (1.0f / D) + EPS);
        const LAS f32x4* gl = (const LAS f32x4*)(X.lds + TL_GAIN); const LAS f32x4* sh = (const LAS f32x4*)(X.lds + TL_MOD + v * 8192); const LAS f32x4* sc = sh + D / 4;
#pragma unroll
        for (int j = 0; j < 4; ++j) { const f32x4 g = gl[lane + 64 * j], s1 = sc[lane + 64 * j], s0 = sh[lane + 64 * j];
            const f32x4 h = (x[j] * rstd * g) * (s1 + 1.0f) + s0; u32x2 o; o.x = cvt_pk_bf16(h[0], h[1]); o.y = cvt_pk_bf16(h[2], h[3]);
            ((u32x2*)(Hb + (size_t)row * D))[lane + 64 * j] = o; }
    }
}

typedef const __attribute__((address_space(4))) Args CArgs;
__device__ __forceinline__ CArgs* get_args() { unsigned long long kp = (unsigned long long)__builtin_amdgcn_kernarg_segment_ptr(); asm volatile("" : "+s"(kp)); return (CArgs*)kp; }
__device__ __forceinline__ Ctx make_ctx(LAS unsigned char* lds, int tid, int bx, int G) {
    Ctx X; X.lds = lds; X.lane = tid & 63; X.wave = __builtin_amdgcn_readfirstlane(tid >> 6);
    X.G = G; X.vcu = (G % 8 == 0) ? (bx % 8) * (G / 8) + bx / 8 : bx;
    X.gw = X.vcu * 8 + X.wave; X.NGW = G * 8; return X;
}
#ifndef PH_MASK
#define PH_MASK 0xffffffffu
#endif
#define PH(n) (((PH_MASK) >> (n)) & 1u)

__global__ void __launch_bounds__(512, 2) mega_fwd(Args a_unused) {
    extern __shared__ __attribute__((aligned(16))) unsigned char lds_raw[];
    LAS unsigned char* const lds = (LAS unsigned char*)lds_raw;
    volatile LAS unsigned* const LC = (volatile LAS unsigned*)(lds + LDSCTL_OFF);
    for (int u = threadIdx.x; u < 128; u += 512) LC[u] = 0u;
    __syncthreads();
    int lo, hi;
    { CArgs* ap = get_args(); lo = ap->ph_lo; hi = ap->ph_hi;
      if (!MK_MULTI) { (void)xcd_barrier_post((unsigned*)(ap->ws + WS_CTL) + CW_BAR, LC); } }
    int step = 0;
#define STEP_ON(k) (step >= lo && step < hi && PH(k))
#define STEP_END do { if (step >= lo && step + 1 < hi) { CArgs* ap_ = get_args(); XcdBarrier b_; b_.bar = (unsigned*)(ap_->ws + WS_CTL) + CW_BAR; b_.x = xb_xcc_id(); b_.st = LC; xcd_barrier(b_); } ++step; } while (0)
#define PHASE_VARS CArgs* ap = get_args(); unsigned char* const ws = ap->ws; int tid = threadIdx.x; asm volatile("" : "+v"(tid)); int bx_ = blockIdx.x, G_ = gridDim.x; asm volatile("" : "+s"(bx_), "+s"(G_)); \
    const Ctx X = make_ctx(lds, tid, bx_, G_); const int lane = X.lane; (void)lane; (void)ws

    if (STEP_ON(0)) {
        PHASE_VARS;
        float* modp = (float*)(ws + WS_MOD); float* rope_m = (float*)(ws + WS_ROPE_MLA); float* rope_g = (float*)(ws + WS_ROPE_GQA);
        LAS float* sl = (LAS float*)(lds + 73728);
        { const float* cin = ap->in[IN_C]; const float* ccin = ap->in[IN_CCTX];
          for (int i = tid; i < 5 * D; i += 512) { const int v = i / D, k = i % D; const float c = v < 4 ? cin[v * D + k] : ccin[k]; sl[i] = c / (1.0f + __expf(-c)); } }
        __syncthreads();
        LAS float* part = (LAS float*)(lds + 73728 + 20480);
        { const float* wada = ap->in[IN_WADA]; const float* bada = ap->in[IN_BADA];
          for (int bi = X.vcu; bi < DEPTH * 96; bi += X.G) {
            const int l = bi / 96, cg = bi % 96, col = cg * 64 + lane;
            const float* wp = wada + (size_t)l * D * 6 * D + col;
            float s0 = 0.f, s1 = 0.f, s2 = 0.f, s3 = 0.f, s4 = 0.f;
#pragma unroll 8
            for (int kk = 0; kk < 128; ++kk) { const int k = X.wave * 128 + kk; const float w = wp[(size_t)k * 6 * D];
                s0 += sl[k] * w; s1 += sl[D + k] * w; s2 += sl[2 * D + k] * w; s3 += sl[3 * D + k] * w; s4 += sl[4 * D + k] * w; }
            part[(X.wave * 5 + 0) * 64 + lane] = s0; part[(X.wave * 5 + 1) * 64 + lane] = s1; part[(X.wave * 5 + 2) * 64 + lane] = s2;
            part[(X.wave * 5 + 3) * 64 + lane] = s3; part[(X.wave * 5 + 4) * 64 + lane] = s4;
            __syncthreads();
            if (tid < 320) { const int v = tid / 64, ln = tid % 64; float s = bada[l * 6 * D + cg * 64 + ln];
#pragma unroll
                for (int w = 0; w < 8; ++w) s += part[(w * 5 + v) * 64 + ln];
                modp[((size_t)(l * 5 + v) * 6) * D + cg * 64 + ln] = s; }
            __syncthreads();
          } }
        { const int gt = X.vcu * 512 + tid;
          if (gt < 128 * 8) { const int pos = gt >> 3, f = gt & 7; float c, s; sincos_d((float)pos * ap->inv_mla[f], c, s); rope_m[pos * 16 + f] = c; rope_m[pos * 16 + 8 + f] = s; }
          else if (gt < 128 * 8 + 128 * 16) { const int g2 = gt - 128 * 8, pos = g2 >> 4, f = g2 & 15; float c, s; sincos_d((float)pos * ap->inv_gqa[f], c, s); rope_g[pos * 32 + f] = c; rope_g[pos * 32 + 16 + f] = s; } }
        int base = 0;
        for (int l = 0; l < DEPTH; ++l) {
            unsigned char* wl = ws + WS_WSM + (size_t)l * LW;
            { const float* w = ap->in[IN_WIN] + (size_t)l * D * 3488; cvt_job<3>(X, base, DINP / 32, D, (bf16_t*)(wl + OFF_WIN), w, w, 3488, 1 << 30); }
            { const float* w = ap->in[IN_WQB] + (size_t)l * 384 * 768; cvt_job<2>(X, base, 24, 384, (bf16_t*)(wl + OFF_WQB), w, w, 768, 1 << 30, ap->in[IN_QNG] + l * 384); }
            { const float* w = ap->in[IN_WKVB] + (size_t)l * 256 * 1024; cvt_job<0>(X, base, 32, 256, (bf16_t*)(wl + OFF_WKVB), w, w, 1024, 1 << 30, ap->in[IN_KVNG] + l * 256); }
            { const float* w = ap->in[IN_WOM] + (size_t)l * 512 * 1024; cvt_job<0>(X, base, 32, 512, (bf16_t*)(wl + OFF_WOM), w, w, 1024, 1 << 30); }
            { const float* w = ap->in[IN_WOG] + (size_t)l * 512 * 1024; cvt_job<0>(X, base, 32, 512, (bf16_t*)(wl + OFF_WOG), w, w, 1024, 1 << 30); }
            { const float* w = ap->in[IN_WOUT] + (size_t)l * 1024 * 1024; cvt_job<0>(X, base, 32, 1024, (bf16_t*)(wl + OFF_WOUT), w, w, 1024, 1 << 30); }
        }
        for (int li = 0; li < 2; ++li) {
            unsigned char* wd = ws + WS_WDEN + (size_t)li * LWD;
            const float* w1 = ap->in[IN_DW1] + (size_t)li * D * FD; const float* w3 = ap->in[IN_DW3] + (size_t)li * D * FD; const float* w2 = ap->in[IN_DW2] + (size_t)li * FD * D;
            cvt_job<1>(X, base, 2 * FD / 32, D, (bf16_t*)wd, w1, w3, FD, 1 << 30);
            cvt_job<0>(X, base, D / 32, FD, (bf16_t*)(wd + SZ_W13D), w2, w2, D, 1 << 30);
        }
        cvt_moe_layer(X, base, ap->in[IN_MW1], ap->in[IN_MW3], ap->in[IN_MW2], ws, 0);
    }
    STEP_END;

    for (int l = 0; l < DEPTH; ++l) {
        const bool moe = (l & 1) != 0, prev_moe = l > 0 && ((l - 1) & 1) != 0; const int last = (l == DEPTH - 1) ? 1 : 0;
        if (STEP_ON(1)) {
            PHASE_VARS;
            bf16_t* XR = (bf16_t*)(ws + WS_XR); bf16_t* Hb = (bf16_t*)(ws + WS_H); const bf16_t* Yg = (const bf16_t*)(ws + WS_YG);
            const float* modp = (const float*)(ws + WS_MOD); const float* modl = modp + (size_t)l * 5 * 6 * D;
            const i32x2* tok_slot = (const i32x2*)(ws + WS_TOK_SLOT); const f32x2* tok_w = (const f32x2*)(ws + WS_TOK_W);
            const float* gain = ap->in[IN_N1G] + l * D; const float* xin = ap->in[IN_X]; const float* cin = ap->in[IN_CTX];
            if (l == 0) norm1_rows<true, false>(X, l, XR, Hb, Yg, modp, tok_slot, tok_w, gain, xin, cin, tid);
            else if (prev_moe) norm1_rows<false, true>(X, l, XR, Hb, Yg, modp, tok_slot, tok_w, gain, xin, cin, tid);
            else norm1_rows<false, false>(X, l, XR, Hb, Yg, modp, tok_slot, tok_w, gain, xin, cin, tid);
            if (l == 2) { __syncthreads(); int base = 0; cvt_moe_layer(X, base, ap->in[IN_MW1], ap->in[IN_MW3], ap->in[IN_MW2], ws, 1); }
        }
        STEP_END;
        if (STEP_ON(2)) {
            PHASE_VARS;
            pg8::Gemm g{(const bf16_t*)(ws + WS_H), (const bf16_t*)(ws + WS_WSM + (size_t)l * LW + OFF_WIN), D, D, D}; pg8::StaticOrder S{T / 256, DINP / 256, X.G, bx_};
            pg8::EpiIn E{(bf16_t*)(ws + WS_Y), (float*)(ws + WS_SSQ_Q), (float*)(ws + WS_SSQ_KV), (bf16_t*)(ws + WS_KM), (const float*)(ws + WS_ROPE_MLA), (const float*)(ws + WS_ROPE_GQA), ap->in[IN_GQG] + l * 64, ap->in[IN_GKG] + l * 64};
            pg8::gemm_phase<pg8::EpiIn, pg8::StaticOrder, true, true>(lds, g, S, E, tid);
        }
        STEP_END;
        if (STEP_ON(4)) {
            PHASE_VARS;
            const bf16_t* Yb = (const bf16_t*)(ws + WS_Y); const unsigned char* wl = ws + WS_WSM + (size_t)l * LW;
            { pg8::Gemm g{Yb + C_QC, (const bf16_t*)(wl + OFF_WQB), DINP, 384, 384}; pg8::StaticOrder S{last ? NB * 32 : T / 256, 3, X.G, bx_, last};
              pg8::EpiQ E{(bf16_t*)(ws + WS_QM), (const float*)(ws + WS_ROPE_MLA), (const float*)(ws + WS_SSQ_Q)}; pg8::gemm_phase<pg8::EpiQ, pg8::StaticOrder, true, true>(lds, g, S, E, tid); }
            { pg8::Gemm g{Yb + C_KVC, (const bf16_t*)(wl + OFF_WKVB), DINP, 256, 256}; pg8::StaticOrder S{T / 256, 4, X.G, bx_};
              pg8::EpiKV E{(bf16_t*)(ws + WS_KM), (bf16_t*)(ws + WS_VM), (const float*)(ws + WS_SSQ_KV)}; pg8::gemm_phase<pg8::EpiKV, pg8::StaticOrder, true, true>(lds, g, S, E, tid); }
        }
        STEP_END;
        if (STEP_ON(5)) {
            PHASE_VARS;
            bf16_t* Yb = (bf16_t*)(ws + WS_Y); bf16_t* Qm = (bf16_t*)(ws + WS_QM); bf16_t* Km = (bf16_t*)(ws + WS_KM); bf16_t* Vm = (bf16_t*)(ws + WS_VM);
            bf16_t* Om = (bf16_t*)(ws + WS_OM); bf16_t* Og = (bf16_t*)(ws + WS_OG);
            const float Cm = 0.10206207261596575f * LOG2E, Cg = 0.125f * LOG2E;
#define ATT_DECODE(L) \
                int b, h, q0, nt; bool gqa; \
                if (L < 2048) { const int pr = (int)(L / 256) * 8 + (int)(L % 8), qb = (int)(L / 8) % 32; q0 = NCTX + qb * 256; nt = TPB / 64; \
                    if (pr < 32) { const int x8 = pr & 7, g = pr >> 3; gqa = true; b = x8 >> 1; h = (x8 & 1) * 4 + g; } \
                    else { const int p2 = pr - 32; gqa = false; b = p2 >> 3; h = p2 & 7; } } \
                else { const int c = (int)(L - 2048); gqa = c < 32; b = (c >> 3) & 3; h = c & 7; q0 = 0; nt = NCTX / 64; } \
                const size_t r0 = (size_t)b * TPB;
            for (int i = 0;; ++i) {
                const long L = (long)i * X.G + bx_; if (L >= (last ? 2048 : 2048 + 64)) break;
                ATT_DECODE(L)
                bool bad;
                if (gqa) { const int kvh = h >> 2;
                    bad = att2::attn_unit<64>(Yb + (r0 + q0) * DINP + C_QG + h * 64, DINP, Yb + r0 * DINP + C_KG + kvh * 64, DINP, Yb + r0 * DINP + C_VG + kvh * 64, DINP,
                                              Og + (r0 + q0) * 512 + h * 64, 512, nt, (LAS char*)lds, tid);
                } else {
                    bad = att2::attn_unit<96>(Qm + (r0 + q0) * 768 + h * 96, 768, Km + r0 * 768 + h * 96, 768, Vm + r0 * 512 + h * 64, 512,
                                              Om + (r0 + q0) * 512 + h * 64, 512, nt, (LAS char*)lds, tid);
                }
                if (bad && lane == 0) __hip_atomic_fetch_or((LAS unsigned*)(LC + 60), 1u << i, __ATOMIC_RELAXED, __HIP_MEMORY_SCOPE_WORKGROUP);
                asm volatile("s_waitcnt lgkmcnt(0)\n\ts_barrier" ::: "memory");
            }
            const unsigned redo = LC[60];
            if (redo != 0u) {
                for (int i = 0; i < 32; ++i) { if (!((redo >> i) & 1u)) continue;
                    const long L = (long)i * X.G + bx_;
                    ATT_DECODE(L)
                    if (gqa) { const int kvh = h >> 2;
                        att::attn_unit<64>(Yb + (r0 + q0) * DINP + C_QG + h * 64, DINP, Yb + r0 * DINP + C_KG + kvh * 64, DINP, Yb + r0 * DINP + C_VG + kvh * 64, DINP,
                                           Og + (r0 + q0) * 512 + h * 64, 512, nt, 1.0f, 8.0f, (LAS char*)lds, tid);
                    } else {
                        att::attn_unit<96>(Qm + (r0 + q0) * 768 + h * 96, 768, Km + r0 * 768 + h * 96, 768, Vm + r0 * 512 + h * 64, 512,
                                           Om + (r0 + q0) * 512 + h * 64, 512, nt, 1.0f, 8.0f, (LAS char*)lds, tid);
                    }
                }
                __syncthreads(); if (tid == 0) LC[60] = 0u;
            }
#undef ATT_DECODE
            __syncthreads();
        }
        STEP_END;
        if (STEP_ON(6)) {
            PHASE_VARS;
            static_assert(WS_OG == WS_OM + (size_t)T * 512 * 2 && OFF_WOG == OFF_WOM + (size_t)1024 * 512 * 2, "pair layout");
            pg8::Gemm g{(const bf16_t*)(ws + WS_OM), (const bf16_t*)(ws + WS_WSM + (size_t)l * LW + OFF_WOM), 512, 512, 512}; pg8::PairOrder S{last ? NB * 32 : T / 256, 4, X.G, bx_, T / 256, 4, last};
            pg8::EpiGate2 E{(bf16_t*)(ws + WS_MG), (const bf16_t*)(ws + WS_Y) + C_GM, (const bf16_t*)(ws + WS_Y) + C_GG}; pg8::gemm_phase<pg8::EpiGate2, pg8::PairOrder, true, true>(lds, g, S, E, tid);
        }
        STEP_END;
        if (STEP_ON(8)) {
            PHASE_VARS;
            pg8::Gemm g{(const bf16_t*)(ws + WS_MG), (const bf16_t*)(ws + WS_WSM + (size_t)l * LW + OFF_WOUT), D, D, D}; pg8::StaticOrder S{last ? NB * 32 : T / 256, 4, X.G, bx_, last};
            pg8::EpiRes E{(bf16_t*)(ws + WS_XR), (const float*)(ws + WS_MOD) + (size_t)l * 5 * 6 * D + 2 * D}; pg8::gemm_phase<pg8::EpiRes, pg8::StaticOrder, true, true>(lds, g, S, E, tid);
        }
        STEP_END;
        if (STEP_ON(9)) {
            PHASE_VARS;
            const bf16_t* XR = (const bf16_t*)(ws + WS_XR); bf16_t* Hb = (bf16_t*)(ws + WS_H); const float* modl = (const float*)(ws + WS_MOD) + (size_t)l * 5 * 6 * D;
            int* cntb = (int*)(ws + WS_CNTB); unsigned* tok_e = (unsigned*)(ws + WS_TOK_E); i32x2* tok_pos = (i32x2*)(ws + WS_TOK_POS); f32x2* tok_w = (f32x2*)(ws + WS_TOK_W);
            const float* gain = ap->in[IN_N2G] + l * D; const float* router = ap->in[IN_ROUTER] + (size_t)(l >> 1) * D * NE;
            f32x4 rt[32];
            if (moe) { if (tid < 8) LC[16 + tid] = 0u;
#pragma unroll
                for (int j = 0; j < 4; ++j)
#pragma unroll
                    for (int qq = 0; qq < 8; ++qq) rt[j * 8 + qq] = ((const f32x4*)(router + (size_t)(4 * (lane + 64 * j)) * NE))[qq]; }
            else {
#pragma unroll
                for (int i = 0; i < 32; ++i) rt[i] = (f32x4){0.f, 0.f, 0.f, 0.f}; }
            lds_fill(lds + TL_GAIN, gain, D / 4, tid);
            for (int v = 0; v < 5; ++v) lds_fill(lds + TL_MOD + v * 8192, modl + ((size_t)v * 6 + 3) * D, 2 * D / 4, tid);
            __syncthreads();
            constexpr int NG = 3;
            u32x2 xn[NG][4];
#pragma unroll
            for (int q = 0; q < NG; ++q) { int r = X.gw + q * X.NGW; r = r < T ? r : T - 1;
#pragma unroll
                for (int j = 0; j < 4; ++j) xn[q][j] = ((const u32x2*)(XR + (size_t)r * D))[lane + 64 * j]; }
            for (int row0 = X.gw; row0 < T; row0 += NG * X.NGW) {
                u32x2 xc[NG][4];
#pragma unroll
                for (int q = 0; q < NG; ++q)
#pragma unroll
                    for (int j = 0; j < 4; ++j) xc[q][j] = xn[q][j];
#pragma unroll
                for (int q = 0; q < NG; ++q) { int r = row0 + (NG + q) * X.NGW; r = r < T ? r : T - 1;
#pragma unroll
                    for (int j = 0; j < 4; ++j) xn[q][j] = ((const u32x2*)(XR + (size_t)r * D))[lane + 64 * j]; }
#pragma unroll
                for (int q = 0; q < NG; ++q) {
                const int row = row0 + q * X.NGW; if (row >= T) break;
                const int b = row / TPB, t = row - b * TPB, v = t < NCTX ? 4 : b;
                if (last && t < NCTX) continue;
                f32x4 x[4]; float ss = 0.f;
#pragma unroll
                for (int j = 0; j < 4; ++j) { x[j] = bf4(xc[q][j]); ss += (x[j][0] * x[j][0] + x[j][1] * x[j][1]) + (x[j][2] * x[j][2] + x[j][3] * x[j][3]); }
                const float rstd = 1.0f / sqrtf(wave_sum(ss) * (1.0f / D) + EPS);
                const LAS f32x4* gl = (const LAS f32x4*)(lds + TL_GAIN); const LAS f32x4* sh = (const LAS f32x4*)(lds + TL_MOD + v * 8192); const LAS f32x4* sc = sh + D / 4;
                float lg0 = 0.f, lg1 = 0.f, lg2 = 0.f, lg3 = 0.f, lg4 = 0.f, lg5 = 0.f, lg6 = 0.f, lg7 = 0.f;
#pragma unroll
                for (int j = 0; j < 4; ++j) { const f32x4 g = gl[lane + 64 * j], s1 = sc[lane + 64 * j], s0 = sh[lane + 64 * j];
                    const f32x4 h = (x[j] * rstd * g) * (s1 + 1.0f) + s0; u32x2 o; o.x = cvt_pk_bf16(h[0], h[1]); o.y = cvt_pk_bf16(h[2], h[3]);
                    ((u32x2*)(Hb + (size_t)row * D))[lane + 64 * j] = o;
                    if (moe) {
#pragma unroll
                        for (int qq = 0; qq < 4; ++qq) { const f32x4 r0 = rt[j * 8 + 2 * qq], r1 = rt[j * 8 + 2 * qq + 1];
                            lg0 += h[qq] * r0[0]; lg1 += h[qq] * r0[1]; lg2 += h[qq] * r0[2]; lg3 += h[qq] * r0[3];
                            lg4 += h[qq] * r1[0]; lg5 += h[qq] * r1[1]; lg6 += h[qq] * r1[2]; lg7 += h[qq] * r1[3]; } } }
                if (moe) {
                    {
                        float t0, t1, t2, t3;
                        { auto r = __builtin_amdgcn_permlane32_swap(__float_as_uint(lg0), __float_as_uint(lg4), false, false); t0 = __uint_as_float(r[0]) + __uint_as_float(r[1]); }
                        { auto r = __builtin_amdgcn_permlane32_swap(__float_as_uint(lg1), __float_as_uint(lg5), false, false); t1 = __uint_as_float(r[0]) + __uint_as_float(r[1]); }
                        { auto r = __builtin_amdgcn_permlane32_swap(__float_as_uint(lg2), __float_as_uint(lg6), false, false); t2 = __uint_as_float(r[0]) + __uint_as_float(r[1]); }
                        { auto r = __builtin_amdgcn_permlane32_swap(__float_as_uint(lg3), __float_as_uint(lg7), false, false); t3 = __uint_as_float(r[0]) + __uint_as_float(r[1]); }
                        const bool b4 = (lane & 16) != 0, b3 = (lane & 8) != 0;
                        const float u0 = (b4 ? t2 : t0) + lane_xor<16>(b4 ? t0 : t2), u1 = (b4 ? t3 : t1) + lane_xor<16>(b4 ? t1 : t3);
                        float w = (b3 ? u1 : u0) + lane_xor<8>(b3 ? u0 : u1);
                        w += lane_xor<4>(w); w += lane_xor<2>(w); w += lane_xor<1>(w);
                        const int wi = (int)__float_as_uint(w);
                        lg0 = __uint_as_float((unsigned)__builtin_amdgcn_readlane(wi, 0));  lg1 = __uint_as_float((unsigned)__builtin_amdgcn_readlane(wi, 8));
                        lg2 = __uint_as_float((unsigned)__builtin_amdgcn_readlane(wi, 16)); lg3 = __uint_as_float((unsigned)__builtin_amdgcn_readlane(wi, 24));
                        lg4 = __uint_as_float((unsigned)__builtin_amdgcn_readlane(wi, 32)); lg5 = __uint_as_float((unsigned)__builtin_amdgcn_readlane(wi, 40));
                        lg6 = __uint_as_float((unsigned)__builtin_amdgcn_readlane(wi, 48)); lg7 = __uint_as_float((unsigned)__builtin_amdgcn_readlane(wi, 56));
                    }
                    float v1 = lg0; int i1 = 0;
#define TOP1(e, x_) if (x_ > v1) { v1 = x_; i1 = e; }
                    TOP1(1, lg1) TOP1(2, lg2) TOP1(3, lg3) TOP1(4, lg4) TOP1(5, lg5) TOP1(6, lg6) TOP1(7, lg7)
#undef TOP1
                    float v2 = -INFINITY; int i2 = 0;
#define TOP2(e, x_) if (i1 != e && x_ > v2) { v2 = x_; i2 = e; }
                    TOP2(0, lg0) TOP2(1, lg1) TOP2(2, lg2) TOP2(3, lg3) TOP2(4, lg4) TOP2(5, lg5) TOP2(6, lg6) TOP2(7, lg7)
#undef TOP2
                    const float ex = __expf(v2 - v1), w1 = 1.0f / (1.0f + ex), w2 = ex * w1;
                    if (lane == 0) { const int pa = (int)__hip_atomic_fetch_add((LAS unsigned*)(LC + 16 + i1), 1u, __ATOMIC_RELAXED, __HIP_MEMORY_SCOPE_WORKGROUP);
                        const int pb = (int)__hip_atomic_fetch_add((LAS unsigned*)(LC + 16 + i2), 1u, __ATOMIC_RELAXED, __HIP_MEMORY_SCOPE_WORKGROUP);
                        tok_e[row] = (unsigned)i1 | ((unsigned)i2 << 8); tok_pos[row] = (i32x2){pa, pb}; tok_w[row] = (f32x2){w1, w2}; }
                }
                }
            }
            if (moe) { __syncthreads(); if (tid < 8) cntb[X.vcu * 8 + tid] = (int)LC[16 + tid]; }
        }
        STEP_END;
        if (!moe) {
            if (STEP_ON(10)) {
                PHASE_VARS;
                pg8::Gemm g{(const bf16_t*)(ws + WS_H), (const bf16_t*)(ws + WS_WDEN + (size_t)(l >> 1) * LWD), D, D, D}; pg8::StaticOrder S{T / 256, 2 * FD / 256, X.G, bx_};
                pg8::EpiSwiglu E{(bf16_t*)(ws + WS_HH), FD, 0}; pg8::gemm_phase<pg8::EpiSwiglu, pg8::StaticOrder, true, true>(lds, g, S, E, tid);
            }
            STEP_END;
            if (STEP_ON(11)) {
                PHASE_VARS;
                pg8::Gemm g{(const bf16_t*)(ws + WS_HH), (const bf16_t*)(ws + WS_WDEN + (size_t)(l >> 1) * LWD + SZ_W13D), FD, FD, FD}; pg8::StaticOrder S{T / 256, 4, X.G, bx_};
                pg8::EpiRes E{(bf16_t*)(ws + WS_XR), (const float*)(ws + WS_MOD) + (size_t)l * 5 * 6 * D + 5 * D}; pg8::gemm_phase<pg8::EpiRes, pg8::StaticOrder, true, true>(lds, g, S, E, tid);
            }
            STEP_END;
        } else {
            if (STEP_ON(12)) {
                PHASE_VARS;
                const int* cntb = (const int*)(ws + WS_CNTB); int* meta = (int*)(ws + WS_META);
                const unsigned* tok_e = (const unsigned*)(ws + WS_TOK_E); const i32x2* tok_pos = (const i32x2*)(ws + WS_TOK_POS); i32x2* tok_slot = (i32x2*)(ws + WS_TOK_SLOT);
                const bf16_t* Hb = (const bf16_t*)(ws + WS_H); bf16_t* Xg = (bf16_t*)(ws + WS_XG);
                { const int e = X.wave; int tot = 0, pre = 0;
                  for (int b0 = 0; b0 < X.G; b0 += 64) { const int bb = b0 + lane; const int c = bb < X.G ? cntb[bb * 8 + e] : 0; tot += c; pre += (bb < X.vcu) ? c : 0; }
                  tot = (int)wave_sum((float)tot); pre = (int)wave_sum((float)pre);
                  if (lane == 0) { LC[24 + e] = (unsigned)tot; LC[32 + e] = (unsigned)pre; } }
                __syncthreads();
                if (tid == 0) { int pbase = 0;
                    for (int e = 0; e < 8; ++e) { const int tot = (int)LC[24 + e], np = (tot + 255) >> 8; LC[40 + e] = (unsigned)(pbase * 256 + (int)LC[32 + e]); pbase += np; LC[48 + e] = (unsigned)pbase; } }
                __syncthreads();
                if (X.vcu == 0 && tid < MAXPAN) { int e = 0;
#pragma unroll
                    for (int q = 0; q < 8; ++q) e += ((int)LC[48 + q] <= tid) ? 1 : 0;
                    meta[16 + tid] = e < 8 ? e : 7; if (tid == 0) meta[0] = (int)LC[55]; }
                unsigned een; i32x2 ppn; u32x4 v0n, v1n;
                { const int row0 = X.gw < T ? X.gw : T - 1; een = tok_e[row0]; ppn = tok_pos[row0]; const u32x4* src = (const u32x4*)(Hb + (size_t)row0 * D); v0n = src[lane]; v1n = src[lane + 64]; }
                for (int row = X.gw; row < T; row += X.NGW) {
                    const unsigned ee = een; const i32x2 pp = ppn; const u32x4 v0 = v0n, v1 = v1n;
                    { const int nrow = row + X.NGW; if (nrow < T) { een = tok_e[nrow]; ppn = tok_pos[nrow]; const u32x4* src = (const u32x4*)(Hb + (size_t)nrow * D); v0n = src[lane]; v1n = src[lane + 64]; } }
                    if (last && (row % TPB) < NCTX) continue;
                    const int sa = (int)LC[40 + (ee & 0xff)] + pp.x, sb = (int)LC[40 + ((ee >> 8) & 0xff)] + pp.y;
                    u32x4* da = (u32x4*)(Xg + (size_t)sa * D); u32x4* db = (u32x4*)(Xg + (size_t)sb * D);
                    da[lane] = v0; da[lane + 64] = v1; db[lane] = v0; db[lane + 64] = v1;
                    if (lane == 0) tok_slot[row] = (i32x2){sa, sb};
                }
            }
            STEP_END;
            for (int ch = 0; ch < MOE_NCH; ++ch) {
                if (STEP_ON(13)) {
                    PHASE_VARS;
                    const int* meta = (const int*)(ws + WS_META);
                    const int P = __builtin_amdgcn_readfirstlane(meta[0]); int np = P - ch * MOE_CH; np = np > MOE_CH ? MOE_CH : np;
                    pg8::Gemm g{(const bf16_t*)(ws + WS_XG), (const bf16_t*)(ws + WS_WMOE13), D, D, D}; pg8::MoeOrder S{ch * MOE_CH, np, 2 * FE / 256, X.G, bx_, 0, meta + 16};
                    pg8::EpiSwiglu E{(bf16_t*)(ws + WS_HHG), FE, ch * MOE_CH}; pg8::gemm_phase<pg8::EpiSwiglu, pg8::MoeOrder, true, true>(lds, g, S, E, tid);
                }
                STEP_END;
                if (STEP_ON(14)) {
                    PHASE_VARS;
                    const int* meta = (const int*)(ws + WS_META);
                    const int P = __builtin_amdgcn_readfirstlane(meta[0]); int np = P - ch * MOE_CH; np = np > MOE_CH ? MOE_CH : np;
                    pg8::Gemm g{(const bf16_t*)(ws + WS_HHG), (const bf16_t*)(ws + WS_WMOE2), FE, FE, FE}; pg8::MoeOrder S{ch * MOE_CH, np, 4, X.G, bx_, ch * MOE_CH, meta + 16};
                    pg8::EpiBf16 E{(bf16_t*)(ws + WS_YG), D, 1 << 30, 0}; pg8::gemm_phase<pg8::EpiBf16, pg8::MoeOrder, true, true>(lds, g, S, E, tid);
                }
                STEP_END;
            }
        }
    }
    if (STEP_ON(15)) {
        PHASE_VARS;
        const bf16_t* XR = (const bf16_t*)(ws + WS_XR); const bf16_t* Yg = (const bf16_t*)(ws + WS_YG); const float* modp = (const float*)(ws + WS_MOD);
        const i32x2* tok_slot = (const i32x2*)(ws + WS_TOK_SLOT); const f32x2* tok_w = (const f32x2*)(ws + WS_TOK_W);
        const float* gain = ap->in[IN_FNG]; float* outp = ap->out;
        lds_fill(lds + TL_GAIN, gain, D / 4, tid);
        for (int v = 0; v < 4; ++v) lds_fill(lds + TL_G2 + v * 4096, modp + ((size_t)((DEPTH - 1) * 5 + v) * 6 + 5) * D, D / 4, tid);
        __syncthreads();
        auto next_lat = [&](int row) { while (row < T && (row % TPB) < NCTX) row += X.NGW; return row; };
        u32x2 xn[4]; i32x2 sln; f32x2 wn;
        int row = next_lat(X.gw);
        { const int row0 = row < T ? row : T - 1;
#pragma unroll
            for (int j = 0; j < 4; ++j) xn[j] = ((const u32x2*)(XR + (size_t)row0 * D))[lane + 64 * j];
            sln = tok_slot[row0]; wn = tok_w[row0]; }
        while (row < T) {
            const int b = row / TPB, t = row - b * TPB;
            f32x4 x[4]; const i32x2 sl = sln; const f32x2 w = wn; u32x2 ya[4], yb[4];
#pragma unroll
            for (int j = 0; j < 4; ++j) { x[j] = bf4(xn[j]); ya[j] = ((const u32x2*)(Yg + (size_t)sl.x * D))[lane + 64 * j]; yb[j] = ((const u32x2*)(Yg + (size_t)sl.y * D))[lane + 64 * j]; }
            const int nrow = next_lat(row + X.NGW);
            if (nrow < T) {
#pragma unroll
                for (int j = 0; j < 4; ++j) xn[j] = ((const u32x2*)(XR + (size_t)nrow * D))[lane + 64 * j];
                sln = tok_slot[nrow]; wn = tok_w[nrow]; }
            { const LAS f32x4* g2 = (const LAS f32x4*)(lds + TL_G2 + b * 4096);
#pragma unroll
              for (int j = 0; j < 4; ++j) { const f32x4 g = g2[lane + 64 * j];
                  x[j][0] += g[0] * (w.x * bflo(ya[j].x) + w.y * bflo(yb[j].x)); x[j][1] += g[1] * (w.x * bfhi(ya[j].x) + w.y * bfhi(yb[j].x));
                  x[j][2] += g[2] * (w.x * bflo(ya[j].y) + w.y * bflo(yb[j].y)); x[j][3] += g[3] * (w.x * bfhi(ya[j].y) + w.y * bfhi(yb[j].y)); } }
            float ss = 0.f;
#pragma unroll
            for (int j = 0; j < 4; ++j) ss += (x[j][0] * x[j][0] + x[j][1] * x[j][1]) + (x[j][2] * x[j][2] + x[j][3] * x[j][3]);
            const float rstd = 1.0f / sqrtf(wave_sum(ss) * (1.0f / D) + EPS);
            float* orow = outp + ((size_t)b * SEQ + (t - NCTX)) * D;
#pragma unroll
            for (int j = 0; j < 4; ++j) { const f32x4 g = ((const LAS f32x4*)(lds + TL_GAIN))[lane + 64 * j]; ((f32x4*)orow)[lane + 64 * j] = x[j] * rstd * g; }
            row = nrow;
        }
    }
    STEP_END;
#undef STEP_ON
#undef STEP_END
#undef PHASE_VARS
}

constexpr int NSTEPS = 1 + DEPTH * 7 + 2 * 2 + 2 * (1 + 2 * MOE_NCH) + 1;
extern "C" void kernel_launch(void* const* d_in, const int* in_sizes, int n_in, void* d_out, int out_size, void* d_ws, size_t ws_size, hipStream_t stream) {
    static int grid = 0;
    if (grid == 0) {
        if (n_in != 26 || in_sizes[0] != NB * SEQ * D || out_size != NB * SEQ * D || ws_size < WS_END) {
            fprintf(stderr, "kernel_launch: shape mismatch: n_in %d in0 %d out %d ws %zu (need >= %zu)\n", n_in, n_in > 0 ? in_sizes[0] : -1, out_size, ws_size, (size_t)WS_END); grid = -1; return; }
        int dev = 0, cus = 0, per_cu = 0;
        if (hipGetDevice(&dev) != hipSuccess || hipDeviceGetAttribute(&cus, hipDeviceAttributeMultiprocessorCount, dev) != hipSuccess) { fprintf(stderr, "kernel_launch: device query failed\n"); grid = -1; return; }
        if (hipFuncSetAttribute((const void*)mega_fwd, hipFuncAttributeMaxDynamicSharedMemorySize, LDS_BYTES) != hipSuccess) { fprintf(stderr, "kernel_launch: hipFuncSetAttribute failed\n"); grid = -1; return; }
        if (hipOccupancyMaxActiveBlocksPerMultiprocessor(&per_cu, (const void*)mega_fwd, 512, LDS_BYTES) != hipSuccess || per_cu < 1)
            fprintf(stderr, "kernel_launch: note: occupancy query reports %d workgroups per CU\n", per_cu);
        (void)hipGetLastError();
        grid = cus;
    }
    if (grid < 0) return;
    if (hipMemsetAsync((char*)d_ws + WS_CTL, 0, CTL_ZERO_BYTES, stream) != hipSuccess) { fprintf(stderr, "kernel_launch: memset failed\n"); return; }
    Args a{};
    for (int i = 0; i < 26; ++i) a.in[i] = (const float*)d_in[i];
    a.out = (float*)d_out; a.ws = (unsigned char*)d_ws;
    for (int f = 0; f < 8; ++f) a.inv_mla[f] = powf(10000.0f, -((float)f * 2.0f) / 16.0f);
    for (int f = 0; f < 16; ++f) a.inv_gqa[f] = powf(10000.0f, -((float)f * 2.0f) / 32.0f);
#if MK_MULTI
    for (int s = 0; s < NSTEPS; ++s) { a.ph_lo = s; a.ph_hi = s + 1; hipLaunchKernelGGL(mega_fwd, dim3(grid), dim3(512), LDS_BYTES, stream, a); }
#else
    a.ph_lo = 0; a.ph_hi = NSTEPS;
    hipLaunchKernelGGL(mega_fwd, dim3(grid), dim3(512), LDS_BYTES, stream, a);
#endif
    const hipError_t le = hipPeekAtLastError();
    if (le != hipSuccess) fprintf(stderr, "kernel_launch: launch failed: %s\n", hipGetErrorName(le));
}
```

```cpp
#include <hip/hip_runtime.h>
#include <cstdio>
#include <cstdint>
#include <cmath>

#ifndef MK_MULTI
#define MK_MULTI 0
#endif

#define LAS __attribute__((address_space(3)))
#define GAS __attribute__((address_space(1)))
typedef unsigned short bf16_t;
typedef short bf16x8 __attribute__((ext_vector_type(8)));
typedef short s16x4 __attribute__((ext_vector_type(4)));
typedef float f32x2 __attribute__((ext_vector_type(2)));
typedef float f32x4 __attribute__((ext_vector_type(4)));
typedef float f32x16 __attribute__((ext_vector_type(16)));
typedef unsigned u32x2 __attribute__((ext_vector_type(2)));
typedef unsigned u32x4 __attribute__((ext_vector_type(4)));
typedef int i32x2 __attribute__((ext_vector_type(2)));

constexpr int D = 1024, NB = 4, SEQ = 8192, NCTX = 256, TPB = SEQ + NCTX  , T = NB * TPB  , DEPTH = 4;
constexpr int PPB = TPB / 256;
constexpr int DINP = 3584;
constexpr int C_QC = 0, C_KVC = 384, C_KPE = 640, C_QG = 768, C_KG = 1280, C_VG = 1408, C_GM = 1536, C_GG = 2560;
constexpr int FD = 2816, FE = 3584, NE = 8;
constexpr float EPS = 1e-6f;
constexpr float LOG2E = 1.4426950408889634f;
constexpr int MOE_CH = 64;
constexpr int MOE_NCH = 5;
constexpr int MAXPAN = 272;

constexpr size_t MiB = 1u << 20;
constexpr size_t WS_CTL = 0, CTL_ZERO_BYTES = 2 * MiB;
constexpr size_t WS_ROPE_MLA = 2 * MiB, WS_ROPE_GQA = 2 * MiB + 16384, WS_MOD = 2 * MiB + 65536;
constexpr size_t WS_CNTB = 3 * MiB, WS_META = 3 * MiB + 65536;
constexpr size_t WS_TOK_E = 4 * MiB, WS_TOK_POS = 4 * MiB + 512 * 1024, WS_TOK_W = 5 * MiB, WS_TOK_SLOT = 5 * MiB + 512 * 1024;
constexpr size_t WS_WSM = 8 * MiB;
constexpr size_t SZ_WIN = (size_t)DINP * D * 2, SZ_WQB = 768 * 384 * 2, SZ_WKVB = 1024 * 256 * 2, SZ_WO = 1024 * 512 * 2, SZ_WOUT = 1024 * 1024 * 2;
constexpr size_t OFF_WIN = 0, OFF_WQB = OFF_WIN + SZ_WIN, OFF_WKVB = OFF_WQB + SZ_WQB, OFF_WOM = OFF_WKVB + SZ_WKVB, OFF_WOG = OFF_WOM + SZ_WO, OFF_WOUT = OFF_WOG + SZ_WO, LW = OFF_WOUT + SZ_WOUT;
constexpr size_t WS_WDEN = 58 * MiB, SZ_W13D = (size_t)2 * FD * D * 2, SZ_W2D = (size_t)D * FD * 2, LWD = SZ_W13D + SZ_W2D;
constexpr size_t WS_WMOE13 = 92 * MiB, WS_WMOE2 = 204 * MiB;
constexpr size_t WS_XR = 260 * MiB;
constexpr size_t WS_BIG = 392 * MiB;
constexpr size_t WS_H = WS_BIG, WS_OM = WS_BIG, WS_OG = WS_BIG + 33 * MiB;
constexpr size_t WS_Y = WS_BIG + 66 * MiB;
constexpr size_t WS_QM = WS_BIG + 297 * MiB, WS_KM = WS_QM + (size_t)T * 768 * 2, WS_VM = WS_KM + (size_t)T * 768 * 2, WS_MG = WS_QM;
constexpr size_t WS_HH = WS_BIG + 66 * MiB;
constexpr size_t WS_XG = WS_BIG + 66 * MiB, WS_HHG = WS_BIG + 202 * MiB, WS_YG = WS_BIG + 314 * MiB;
constexpr size_t WS_SSQ_Q = WS_BIG + 450 * MiB, WS_SSQ_KV = WS_SSQ_Q + 2 * MiB;
constexpr size_t WS_END = WS_BIG + 454 * MiB;
static_assert(WS_WSM + 4 * LW <= WS_WDEN && WS_WDEN + 2 * LWD <= WS_WMOE13, "small weights");
static_assert(WS_WMOE13 + (size_t)NE * 2 * FE * D * 2 <= WS_WMOE2 && WS_WMOE2 + (size_t)NE * D * FE * 2 <= WS_XR, "moe weights");
static_assert(WS_XR + (size_t)T * D * 4 <= WS_BIG, "xr");
static_assert(WS_H + (size_t)T * D * 2 <= WS_Y && WS_Y + (size_t)T * DINP * 2 <= WS_QM && WS_VM + (size_t)T * 512 * 2 <= WS_END, "attn stage");
static_assert(WS_HH + (size_t)T * FD * 2 <= WS_END, "dense stage");
static_assert(WS_XG + (size_t)MAXPAN * 256 * D * 2 <= WS_HHG && WS_HHG + (size_t)MOE_CH * 256 * FE * 2 <= WS_YG && WS_YG + (size_t)MAXPAN * 256 * D * 2 <= WS_END, "moe stage");
static_assert(WS_MOD + (size_t)DEPTH * 5 * 6 * D * 4 <= WS_CNTB, "mod");
constexpr int CW_BAR = 4096;

constexpr int RING_BYTES = 131072;
constexpr int LDSCTL_OFF = RING_BYTES;
constexpr int LDS_BYTES = 147456;

__device__ __forceinline__ unsigned cvt_pk_bf16(float lo, float hi) { unsigned r; asm volatile("v_cvt_pk_bf16_f32 %0, %1, %2" : "=v"(r) : "v"(lo), "v"(hi)); return r; }
__device__ __forceinline__ float bflo(unsigned w) { return __uint_as_float(w << 16); }
__device__ __forceinline__ float bfhi(unsigned w) { return __uint_as_float(w & 0xffff0000u); }
__device__ __forceinline__ float bf1(bf16_t h) { return __uint_as_float((unsigned)h << 16); }
__device__ __forceinline__ f32x4 bf4(u32x2 w) { return (f32x4){bflo(w.x), bfhi(w.x), bflo(w.y), bfhi(w.y)}; }
__device__ __forceinline__ float fast_sigmoid(float x) { return __builtin_amdgcn_rcpf(1.0f + __builtin_amdgcn_exp2f(-x * LOG2E)); }
template <int M> __device__ __forceinline__ float lane_xor(float v) {
    if constexpr (M == 32) { auto rr = __builtin_amdgcn_permlane32_swap(__float_as_uint(v), __float_as_uint(v), false, false); return __uint_as_float((threadIdx.x & 32) ? rr[0] : rr[1]); }
    else return __uint_as_float((unsigned)__builtin_amdgcn_ds_swizzle((int)__float_as_uint(v), (M << 10) | 0x1f));
}
__device__ __forceinline__ float wave_sum(float v) {
    v += lane_xor<1>(v); v += lane_xor<2>(v); v += lane_xor<4>(v); v += lane_xor<8>(v); v += lane_xor<16>(v);
    { auto rr = __builtin_amdgcn_permlane32_swap(__float_as_uint(v), __float_as_uint(v), false, false); v = __uint_as_float(rr[0]) + __uint_as_float(rr[1]); }
    return v;
}

namespace pg8 {
constexpr int BM = 256, BK = 64, HALF = 128, HTB = HALF * BK * 2, STAGE_BYTES = 8 * HTB, NXCD = 8, WGM = 8;
__host__ __device__ __forceinline__ int lds_byte(int r, int c) { const int st = (r >> 4) * 2 + (c >> 5), rr = r & 15, cc = c & 31, ob = rr * 64 + cc * 2; return st * 1024 + (ob ^ (((ob >> 9) & 1) << 5)); }
__host__ __device__ __forceinline__ void stage_rc(int b, int& R, int& C) { const int st = b / 1024, sb = b % 1024, swz = sb ^ (((sb >> 9) & 1) << 5); R = (st >> 1) * 16 + swz / 64; C = (st & 1) * 32 + (swz % 64) / 2; }
__host__ __device__ __forceinline__ int perm32(int rho) { const int n = rho >> 4, i = rho & 15; return 8 * (i >> 2) + 4 * n + (i & 3); }

struct Unit { int pa, pb, pm, pn; };
struct Gemm { const bf16_t* A; const bf16_t* Bt; int lda, ldb, K; };

__device__ __forceinline__ bool tile_order(long L, int nM, int nN, int& pm, int& pn) {
    const int nwg = nM * nN; if (L >= nwg) return false;
    int wgid = (int)L; { const int q = nwg / NXCD, r = nwg % NXCD, xcd = wgid % NXCD, off = wgid / NXCD; wgid = (xcd < r ? xcd * (q + 1) : r * (q + 1) + (xcd - r) * q) + off; }
    const int nig = WGM * nN, gid = wgid / nig, fm = gid * WGM, gsz = (nM - fm) < WGM ? (nM - fm) : WGM;
    pm = fm + ((wgid % nig) % gsz); pn = (wgid % nig) / gsz; return true;
}
struct StaticOrder {
    static constexpr bool PAIRED = false;
    int nM, nN, G, c; int latent_only = 0;
    __device__ __forceinline__ bool next(int i, Unit& u) const {
        int pm, pn; if (!tile_order((long)i * G + c, nM, nN, pm, pn)) return false;
        if (latent_only) pm += (pm >> 5) + 1;
        u.pa = pm; u.pb = pn; u.pm = pm; u.pn = pn; return true;
    }
};
struct MoeOrder {
    static constexpr bool PAIRED = false;
    int p0, np, nN, G, c, aoff; const int* pexp;
    __device__ __forceinline__ bool next(int i, Unit& u) const {
        if (np <= 0) return false;
        int pm, pn; if (!tile_order((long)i * G + c, np, nN, pm, pn)) return false;
        pm += p0; const int e = __builtin_amdgcn_readfirstlane(pexp[pm]);
        u.pa = pm - aoff; u.pb = e * nN + pn; u.pm = pm; u.pn = pn; return true;
    }
};

struct PairOrder {
    static constexpr bool PAIRED = true;
    int nM, nN, G, c, dpa, dpb; int latent_only = 0;
    __device__ __forceinline__ bool next(int i, Unit& u) const {
        const int j = i >> 1, seg = i & 1; int pm, pn; if (!tile_order((long)j * G + c, nM, nN, pm, pn)) return false;
        if (latent_only) pm += (pm >> 5) + 1;
        u.pa = pm + seg * dpa; u.pb = pn + seg * dpb; u.pm = pm; u.pn = pn; return true;
    }
};

template <class Epi, class Sched, bool ALIGN_EPI, bool SP2>
__device__ __forceinline__ void gemm_phase(LAS unsigned char* lds, const Gemm g, const Sched& S, const Epi& E, const int tid) {
    const int wid = __builtin_amdgcn_readfirstlane(tid >> 6), lane = tid & 63, wr = wid >> 2, wc = wid & 3, fr = lane & 15, fq = lane >> 4;
    const int K = g.K, nt = K / BK;
    unsigned voffA[2], voffB[2];
#pragma unroll
    for (int i = 0; i < 2; ++i) { int R, C; stage_rc(tid * 16 + i * 8192, R, C); const int Rb = Epi::PERM ? ((R & ~31) + perm32(R & 31)) : R;
        voffA[i] = (unsigned)(R * g.lda + C) * 2u; voffB[i] = (unsigned)(Rb * g.ldb + C) * 2u; }
    const size_t kstep = (size_t)(BK * 2);
    const size_t hstepA = (size_t)HALF * g.lda * 2, hstepB = (size_t)HALF * g.ldb * 2;
    const size_t tstepA = 2 * hstepA, tstepB = 2 * hstepB;
    const unsigned ldsw = (unsigned)wid * 1024u;
    const int aoff = lds_byte(wr * 64 + fr, fq * 8), boff = lds_byte(wc * 32 + fr, fq * 8);
#define PG8_SA(b, h) (((b) * 2 + (h)) * HTB)
#define PG8_SB(b, h) ((4 + (b) * 2 + (h)) * HTB)
#define PG8_STAGE(bufoff, gbase, voff) do { _Pragma("unroll") for (int _i = 0; _i < 2; ++_i) \
        __builtin_amdgcn_global_load_lds((const unsigned*)((const char*)(gbase) + (voff)[_i]), (LAS unsigned*)(lds + (bufoff) + ldsw + _i * 8192), 16, 0, 0); } while (0)
#define PG8_LDA(dst, b, h) do { _Pragma("unroll") for (int m = 0; m < 4; ++m) _Pragma("unroll") for (int k = 0; k < 2; ++k) dst[m][k] = *(const LAS bf16x8*)(lds + PG8_SA(b, h) + aoff + m * 2048 + k * 1024); } while (0)
#define PG8_LDB(dst, b, h) do { _Pragma("unroll") for (int n = 0; n < 2; ++n) _Pragma("unroll") for (int k = 0; k < 2; ++k) dst[n][k] = *(const LAS bf16x8*)(lds + PG8_SB(b, h) + boff + n * 2048 + k * 1024); } while (0)
#define PG8_MMA(ai, bj, At, Bt) do { __builtin_amdgcn_s_setprio(1); _Pragma("unroll") for (int m = 0; m < 4; ++m) _Pragma("unroll") for (int n = 0; n < 2; ++n) _Pragma("unroll") for (int k = 0; k < 2; ++k) \
        acc[ai][bj][m][n] = __builtin_amdgcn_mfma_f32_16x16x32_bf16(Bt[n][k], At[m][k], acc[ai][bj][m][n], 0, 0, 0); __builtin_amdgcn_s_setprio(0); } while (0)
#define PG8_WAIT_V(n) asm volatile("s_waitcnt vmcnt(" #n ")" ::: "memory")
#define PG8_WAIT_L(n) asm volatile("s_waitcnt lgkmcnt(" #n ")" ::: "memory")
#define PG8_BAR __builtin_amdgcn_s_barrier()
#define PG8_SCHED __builtin_amdgcn_sched_barrier(0)
    Unit cur, nxt; int ui = 0;
    if (!S.next(0, cur)) return;
    f32x4 acc[2][2][4][2];
#pragma unroll
    for (int a = 0; a < 2; ++a)
#pragma unroll
        for (int b = 0; b < 2; ++b)
#pragma unroll
            for (int m = 0; m < 4; ++m)
#pragma unroll
                for (int n = 0; n < 2; ++n) acc[a][b][m][n] = (f32x4){0.f, 0.f, 0.f, 0.f};
    bf16x8 At[4][2], B0[2][2], B1[2][2];
    const char* cA = (const char*)g.A + (size_t)cur.pa * tstepA; const char* cB = (const char*)g.Bt + (size_t)cur.pb * tstepB;
    if constexpr (SP2) {
        PG8_STAGE(PG8_SB(0, 0), cB, voffB); PG8_STAGE(PG8_SB(0, 1), cB + hstepB, voffB); PG8_STAGE(PG8_SA(0, 0), cA, voffA); PG8_STAGE(PG8_SA(0, 1), cA + hstepA, voffA);
        if (wr == 1) PG8_BAR;
        PG8_WAIT_V(2); PG8_BAR;
        PG8_STAGE(PG8_SB(1, 0), cB + kstep, voffB); PG8_STAGE(PG8_SA(1, 0), cA + kstep, voffA); PG8_STAGE(PG8_SB(1, 1), cB + hstepB + kstep, voffB);
        PG8_WAIT_V(6); PG8_BAR;
    } else {
        PG8_STAGE(PG8_SB(0, 0), cB, voffB); PG8_STAGE(PG8_SA(0, 0), cA, voffA); PG8_STAGE(PG8_SB(0, 1), cB + hstepB, voffB); PG8_STAGE(PG8_SA(0, 1), cA + hstepA, voffA);
        if (wr == 1) PG8_BAR;
        PG8_WAIT_V(4); PG8_BAR;
        PG8_STAGE(PG8_SB(1, 0), cB + kstep, voffB); PG8_STAGE(PG8_SA(1, 0), cA + kstep, voffA); PG8_STAGE(PG8_SB(1, 1), cB + hstepB + kstep, voffB);
        PG8_WAIT_V(6); PG8_BAR;
    }
    for (;;) {
        const bool has_next = S.next(ui + 1, nxt);
        const char* nA = has_next ? (const char*)g.A + (size_t)nxt.pa * tstepA : cA; const char* nB = has_next ? (const char*)g.Bt + (size_t)nxt.pb * tstepB : cB;
#pragma clang loop unroll(disable)
        for (int t = 0; t < nt; t += 2) {
            const bool last = (t == nt - 2);
            const char* a1 = cA + (size_t)(t + 1) * kstep;
            const char* a2 = last ? nA : cA + (size_t)(t + 2) * kstep; const char* b2 = last ? nB : cB + (size_t)(t + 2) * kstep;
            const char* a3 = a2 + kstep; const char* b3 = b2 + kstep;
            if constexpr (SP2) {
            PG8_LDB(B0, 0, 0); PG8_LDB(B1, 0, 1); PG8_SCHED; PG8_LDA(At, 0, 0); PG8_STAGE(PG8_SA(1, 1), a1 + hstepA, voffA);
            PG8_WAIT_V(8); PG8_WAIT_L(0); PG8_BAR; PG8_MMA(0, 0, At, B0); PG8_MMA(0, 1, At, B1); PG8_BAR; PG8_SCHED;
            PG8_LDA(At, 0, 1); PG8_STAGE(PG8_SB(0, 0), b2, voffB); PG8_STAGE(PG8_SB(0, 1), b2 + hstepB, voffB); PG8_STAGE(PG8_SA(0, 0), a2, voffA);
            PG8_WAIT_V(8); PG8_WAIT_L(0); PG8_BAR; PG8_MMA(1, 0, At, B0); PG8_MMA(1, 1, At, B1); PG8_BAR; PG8_SCHED;
            PG8_LDB(B0, 1, 0); PG8_LDB(B1, 1, 1); PG8_SCHED; PG8_LDA(At, 1, 0); PG8_STAGE(PG8_SA(0, 1), a2 + hstepA, voffA);
            PG8_WAIT_V(8); PG8_WAIT_L(0); PG8_BAR; PG8_MMA(0, 0, At, B0); PG8_MMA(0, 1, At, B1); PG8_BAR; PG8_SCHED;
            PG8_LDA(At, 1, 1); PG8_STAGE(PG8_SB(1, 0), b3, voffB); PG8_STAGE(PG8_SB(1, 1), b3 + hstepB, voffB); PG8_STAGE(PG8_SA(1, 0), a3, voffA);
            PG8_WAIT_V(8); PG8_WAIT_L(0); PG8_BAR; PG8_MMA(1, 0, At, B0); PG8_MMA(1, 1, At, B1); PG8_BAR; PG8_SCHED;
            } else {
            PG8_LDB(B0, 0, 0); PG8_SCHED; PG8_LDA(At, 0, 0); PG8_STAGE(PG8_SA(1, 1), a1 + hstepA, voffA);
            PG8_WAIT_L(8); PG8_BAR; PG8_WAIT_L(0); PG8_MMA(0, 0, At, B0); PG8_BAR; PG8_SCHED;
            PG8_LDB(B1, 0, 1); PG8_STAGE(PG8_SB(0, 0), b2, voffB);
            PG8_BAR; PG8_WAIT_L(0); PG8_MMA(0, 1, At, B1); PG8_BAR;
            PG8_LDA(At, 0, 1); PG8_STAGE(PG8_SA(0, 0), a2, voffA);
            PG8_BAR; PG8_WAIT_L(0); PG8_MMA(1, 0, At, B0); PG8_BAR; PG8_SCHED;
            PG8_STAGE(PG8_SB(0, 1), b2 + hstepB, voffB);
            PG8_WAIT_V(6); PG8_BAR; PG8_MMA(1, 1, At, B1); PG8_BAR;
            PG8_LDB(B0, 1, 0); PG8_SCHED; PG8_LDA(At, 1, 0); PG8_STAGE(PG8_SA(0, 1), a2 + hstepA, voffA);
            PG8_WAIT_L(8); PG8_BAR; PG8_WAIT_L(0); PG8_MMA(0, 0, At, B0); PG8_BAR; PG8_SCHED;
            PG8_LDB(B1, 1, 1); PG8_STAGE(PG8_SB(1, 0), b3, voffB);
            PG8_BAR; PG8_WAIT_L(0); PG8_MMA(0, 1, At, B1); PG8_BAR;
            PG8_LDA(At, 1, 1); PG8_STAGE(PG8_SA(1, 0), a3, voffA);
            PG8_BAR; PG8_WAIT_L(0); PG8_MMA(1, 0, At, B0); PG8_BAR; PG8_SCHED;
            PG8_STAGE(PG8_SB(1, 1), b3 + hstepB, voffB);
            PG8_WAIT_V(6); PG8_BAR; PG8_MMA(1, 1, At, B1); PG8_BAR;
            }
        }
        if constexpr (ALIGN_EPI) { if (wr == 0) PG8_BAR; }
        bool fin = true;
        if constexpr (Sched::PAIRED) { fin = (cur.pa != cur.pm); if (fin) E(acc, cur, wr, wc, fr, fq); else E.mid(acc, cur, wr, wc, fr, fq); }
        else E(acc, cur, wr, wc, fr, fq);
        if (!has_next) break;
        if (fin) {
#pragma unroll
        for (int a = 0; a < 2; ++a)
#pragma unroll
            for (int b = 0; b < 2; ++b)
#pragma unroll
                for (int m = 0; m < 4; ++m)
#pragma unroll
                    for (int n = 0; n < 2; ++n) acc[a][b][m][n] = (f32x4){0.f, 0.f, 0.f, 0.f};
        }
        cur = nxt; cA = nA; cB = nB; ++ui;
        if constexpr (ALIGN_EPI) { if (wr == 1) PG8_BAR; }
    }
    PG8_WAIT_V(0);
    if constexpr (!ALIGN_EPI) { if (wr == 0) PG8_BAR; }
    PG8_BAR;
#undef PG8_SA
#undef PG8_SB
#undef PG8_STAGE
#undef PG8_LDA
#undef PG8_LDB
#undef PG8_MMA
#undef PG8_WAIT_V
#undef PG8_WAIT_L
#undef PG8_BAR
#undef PG8_SCHED
}

__device__ __forceinline__ u32x4 pack8(const f32x4 v0, const f32x4 v1) {
    u32x4 w; w.x = cvt_pk_bf16(v0[0], v0[1]); w.y = cvt_pk_bf16(v0[2], v0[3]); w.z = cvt_pk_bf16(v1[0], v1[1]); w.w = cvt_pk_bf16(v1[2], v1[3]); return w;
}
struct EpiBf16 {
    static constexpr bool PERM = true;
    bf16_t* O; int ldc; int sig_from; int prow_off;
    __device__ __forceinline__ void operator()(const f32x4 (&acc)[2][2][4][2], const Unit& u, int wr, int wc, int fr, int fq) const {
        const int row0 = (u.pm - prow_off) * BM + wr * 64 + fr, col0 = u.pn * BM + wc * 32 + 8 * fq;
#pragma unroll
        for (int ai = 0; ai < 2; ++ai)
#pragma unroll
            for (int m = 0; m < 4; ++m) { bf16_t* rowp = O + (size_t)(row0 + ai * HALF + m * 16) * ldc + col0;
#pragma unroll
                for (int bj = 0; bj < 2; ++bj) { f32x4 v0 = acc[ai][bj][m][0], v1 = acc[ai][bj][m][1];
                    if (col0 + bj * HALF >= sig_from) {
#pragma unroll
                        for (int q = 0; q < 4; ++q) { v0[q] = fast_sigmoid(v0[q]); v1[q] = fast_sigmoid(v1[q]); } }
                    *(u32x4*)(rowp + bj * HALF) = pack8(v0, v1); } }
    }
};
struct EpiIn {
    static constexpr bool PERM = true;
    bf16_t* O; float* ssq_q; float* ssq_kv; bf16_t* Km; const float* rope_m; const float* rope_g; const float* gq; const float* gk;
    __device__ __forceinline__ void operator()(const f32x4 (&acc)[2][2][4][2], const Unit& u, int wr, int wc, int fr, int fq) const {
        const int row0 = u.pm * BM + wr * 64 + fr, col0 = u.pn * BM + wc * 32 + 8 * fq;
        const int tp = u.pm % PPB; const bool rot = tp != 0;
        const bool isq = u.pn < 5, ishead = (u.pn == 3) || (u.pn == 4) || (u.pn == 5 && wc < 2), isv = (u.pn == 5 && wc >= 2), gate = u.pn >= 6, kpe = (u.pn == 2 && wc == 0);
        int cb0 = col0, cb1 = col0 + HALF;
        if (ishead) { const int head = isq ? 4 * (u.pn - 3) + wc : wc; cb0 = (isq ? C_QG : C_KG) + head * 64 + 8 * fq; cb1 = cb0 + 32; }
        if (isv) { cb0 = C_VG + (wc - 2) * 64 + 8 * fq; cb1 = cb0 + 32; }
        const float* gg = (isq ? gq : gk) + 8 * fq; const float qs = isq ? 0.125f * LOG2E : 1.0f;
        const int f0 = (fq & 1) * 8; const bool up = (fq & 2) != 0;
#pragma unroll
        for (int ai = 0; ai < 2; ++ai)
#pragma unroll
            for (int m = 0; m < 4; ++m) { const int row = row0 + ai * HALF + m * 16; bf16_t* rowp = O + (size_t)row * DINP;
                f32x4 v[2][2] = {{acc[ai][0][m][0], acc[ai][0][m][1]}, {acc[ai][1][m][0], acc[ai][1][m][1]}};
                const int grow = (tp - 1) * 4 + 2 * ai + wr, gcol = 16 * m + fr;
                if (u.pn < 3) {
                    float sq[2];
#pragma unroll
                    for (int bj = 0; bj < 2; ++bj) { const f32x4 a = v[bj][0], b = v[bj][1];
                        float t = (a[0] * a[0] + a[1] * a[1]) + (a[2] * a[2] + a[3] * a[3]) + (b[0] * b[0] + b[1] * b[1]) + (b[2] * b[2] + b[3] * b[3]);
                        t += lane_xor<16>(t); { auto rr = __builtin_amdgcn_permlane32_swap(__float_as_uint(t), __float_as_uint(t), false, false); t = __uint_as_float(rr[0]) + __uint_as_float(rr[1]); }
                        sq[bj] = t; }
                    if (fq == 0) {
                        if (u.pn == 0) ssq_q[(size_t)row * 8 + wc] = sq[0] + sq[1];
                        else if (u.pn == 1) { ssq_q[(size_t)row * 8 + 4 + wc] = sq[0]; ssq_kv[(size_t)row * 8 + wc] = sq[1]; }
                        else ssq_kv[(size_t)row * 8 + 4 + wc] = sq[0]; }
                    if (kpe) {
                        const int pos = (fq < 2) ? grow : gcol;
                        f32x4 c0 = (f32x4){1.f, 1.f, 1.f, 1.f}, c1 = c0, s0 = (f32x4){0.f, 0.f, 0.f, 0.f}, s1 = s0;
                        if (rot) { const f32x4* rp = (const f32x4*)(rope_m + pos * 16); c0 = rp[0]; c1 = rp[1]; s0 = rp[2]; s1 = rp[3]; }
                        if (!(fq & 1)) { s0 = -s0; s1 = -s1; }
                        f32x4 p0, p1;
#pragma unroll
                        for (int q = 0; q < 4; ++q) { p0[q] = lane_xor<16>(v[1][0][q]); p1[q] = lane_xor<16>(v[1][1][q]); }
                        const u32x4 ow = pack8(v[1][0] * c0 + p0 * s0, v[1][1] * c1 + p1 * s1);
#pragma unroll
                        for (int h = 0; h < 8; ++h) *(u32x4*)(Km + (size_t)row * 768 + h * 96 + 64 + 8 * fq) = ow; }
                }
                if (ishead) {
                    float ss = 0.f;
#pragma unroll
                    for (int bj = 0; bj < 2; ++bj)
#pragma unroll
                        for (int n = 0; n < 2; ++n) { const f32x4 x = v[bj][n]; ss += (x[0] * x[0] + x[1] * x[1]) + (x[2] * x[2] + x[3] * x[3]); }
                    ss += lane_xor<16>(ss); { auto rr = __builtin_amdgcn_permlane32_swap(__float_as_uint(ss), __float_as_uint(ss), false, false); ss = __uint_as_float(rr[0]) + __uint_as_float(rr[1]); }
                    const float rstd = 1.0f / sqrtf(ss * (1.0f / 64.0f) + EPS);
#pragma unroll
                    for (int bj = 0; bj < 2; ++bj) {
                        const f32x4 g0 = *(const f32x4*)(gg + 32 * bj), g1 = *(const f32x4*)(gg + 32 * bj + 4);
                        const f32x4 y0 = v[bj][0] * rstd * g0, y1 = v[bj][1] * rstd * g1;
                        f32x4 c0 = (f32x4){1.f, 1.f, 1.f, 1.f}, c1 = c0, s0 = (f32x4){0.f, 0.f, 0.f, 0.f}, s1 = s0;
                        if (rot) { const f32x4* rp = (const f32x4*)(rope_g + (bj ? gcol : grow) * 32 + f0); c0 = rp[0]; c1 = rp[1]; s0 = rp[4]; s1 = rp[5]; }
                        if (!up) { s0 = -s0; s1 = -s1; }
                        f32x4 p0, p1;
#pragma unroll
                        for (int q = 0; q < 4; ++q) {
                            { auto rr = __builtin_amdgcn_permlane32_swap(__float_as_uint(y0[q]), __float_as_uint(y0[q]), false, false); p0[q] = __uint_as_float(up ? rr[0] : rr[1]); }
                            { auto rr = __builtin_amdgcn_permlane32_swap(__float_as_uint(y1[q]), __float_as_uint(y1[q]), false, false); p1[q] = __uint_as_float(up ? rr[0] : rr[1]); } }
                        v[bj][0] = (y0 * c0 + p0 * s0) * qs; v[bj][1] = (y1 * c1 + p1 * s1) * qs; }
                }
                if (gate) {
#pragma unroll
                    for (int bj = 0; bj < 2; ++bj)
#pragma unroll
                        for (int q = 0; q < 4; ++q) { v[bj][0][q] = fast_sigmoid(v[bj][0][q]); v[bj][1][q] = fast_sigmoid(v[bj][1][q]); } }
                *(u32x4*)(rowp + cb0) = pack8(v[0][0], v[0][1]);
                if (u.pn != 2) *(u32x4*)(rowp + cb1) = pack8(v[1][0], v[1][1]);
            }
    }
};
struct EpiQ {
    static constexpr bool PERM = true; static constexpr float QSC = 0.10206207261596575f * LOG2E;
    bf16_t* Qm; const float* rope; const float* ssq;
    __device__ __forceinline__ float rstd_of(size_t row) const { const f32x4 a = *(const f32x4*)(ssq + row * 8), b = *(const f32x4*)(ssq + row * 8 + 4);
        return 1.0f / sqrtf(((a[0] + a[1]) + (a[2] + a[3]) + (b[0] + b[1]) + (b[2] + b[3])) * (1.0f / 384.0f) + EPS); }
    __device__ __forceinline__ void operator()(const f32x4 (&acc)[2][2][4][2], const Unit& u, int wr, int wc, int fr, int fq) const {
        const int row0 = u.pm * BM + wr * 64 + fr;
        if (u.pn < 2) {
#pragma unroll
            for (int bj = 0; bj < 2; ++bj) { const int c = u.pn * BM + bj * HALF + wc * 32 + 8 * fq, h = c >> 6, d = c & 63;
#pragma unroll
                for (int ai = 0; ai < 2; ++ai)
#pragma unroll
                    for (int m = 0; m < 4; ++m) { const size_t row = (size_t)(row0 + ai * HALF + m * 16); const float sc = QSC * rstd_of(row);
                        *(u32x4*)(Qm + row * 768 + h * 96 + d) = pack8(acc[ai][bj][m][0] * sc, acc[ai][bj][m][1] * sc); } }
        } else {
            const int tp = u.pm % PPB; const bool rot = tp != 0;
#pragma unroll
            for (int ai = 0; ai < 2; ++ai)
#pragma unroll
                for (int m = 0; m < 4; ++m) {
                    const int grow = (tp - 1) * 4 + 2 * ai + wr, gcol = 16 * m + fr, pos = (fq < 2) ? grow : gcol;
                    f32x4 c0 = (f32x4){1.f, 1.f, 1.f, 1.f}, c1 = c0, s0 = (f32x4){0.f, 0.f, 0.f, 0.f}, s1 = s0;
                    if (rot) { const f32x4* rp = (const f32x4*)(rope + pos * 16); c0 = rp[0]; c1 = rp[1]; s0 = rp[2]; s1 = rp[3]; }
                    const float sc = QSC * rstd_of((size_t)(row0 + ai * HALF + m * 16));
                    if (!(fq & 1)) { s0 = -s0; s1 = -s1; }
#pragma unroll
                    for (int bj = 0; bj < 2; ++bj) { const int h = 4 * bj + wc;
                        const f32x4 v0 = acc[ai][bj][m][0], v1 = acc[ai][bj][m][1]; f32x4 p0, p1;
#pragma unroll
                        for (int q = 0; q < 4; ++q) { p0[q] = lane_xor<16>(v0[q]); p1[q] = lane_xor<16>(v1[q]); }
                        const f32x4 o0 = (v0 * c0 + p0 * s0) * sc, o1 = (v1 * c1 + p1 * s1) * sc;
                        *(u32x4*)(Qm + (size_t)(row0 + ai * HALF + m * 16) * 768 + h * 96 + 64 + 8 * fq) = pack8(o0, o1); }
                    asm volatile("" ::: "memory"); __builtin_amdgcn_sched_barrier(0);
                }
        }
    }
};
struct EpiKV {
    static constexpr bool PERM = true;
    bf16_t* Km; bf16_t* Vm; const float* ssq;
    __device__ __forceinline__ void operator()(const f32x4 (&acc)[2][2][4][2], const Unit& u, int wr, int wc, int fr, int fq) const {
        const int row0 = u.pm * BM + wr * 64 + fr;
#pragma unroll
        for (int bj = 0; bj < 2; ++bj) { const int h = 2 * u.pn + bj, j = wc * 32 + 8 * fq;
            bf16_t* base = (j < 64) ? Km + h * 96 + j : Vm + h * 64 + (j - 64); const int ld = (j < 64) ? 768 : 512;
#pragma unroll
            for (int ai = 0; ai < 2; ++ai)
#pragma unroll
                for (int m = 0; m < 4; ++m) { const size_t row = (size_t)(row0 + ai * HALF + m * 16);
                    const f32x4 a = *(const f32x4*)(ssq + row * 8), b = *(const f32x4*)(ssq + row * 8 + 4);
                    const float sc = 1.0f / sqrtf(((a[0] + a[1]) + (a[2] + a[3]) + (b[0] + b[1]) + (b[2] + b[3])) * (1.0f / 256.0f) + EPS);
                    *(u32x4*)(base + row * ld) = pack8(acc[ai][bj][m][0] * sc, acc[ai][bj][m][1] * sc); } }
    }
};
struct EpiGate2 {
    static constexpr bool PERM = true;
    bf16_t* MG; const bf16_t* gm; const bf16_t* gg;
    __device__ __forceinline__ void mid(f32x4 (&acc)[2][2][4][2], const Unit& u, int wr, int wc, int fr, int fq) const {
        const int row0 = u.pm * BM + wr * 64 + fr, col0 = u.pn * BM + wc * 32 + 8 * fq;
#pragma unroll
        for (int ai = 0; ai < 2; ++ai)
#pragma unroll
            for (int m = 0; m < 4; ++m) { const size_t row = (size_t)(row0 + ai * HALF + m * 16);
#pragma unroll
                for (int bj = 0; bj < 2; ++bj) { const int c = col0 + bj * HALF;
                    const u32x4 a = *(const u32x4*)(gm + row * DINP + c), b = *(const u32x4*)(gg + row * DINP + c);
                    f32x4& v0 = acc[ai][bj][m][0]; f32x4& v1 = acc[ai][bj][m][1];
                    v0[0] *= bflo(a.x) * __builtin_amdgcn_rcpf(fmaxf(bflo(b.x), 1e-30f)); v0[1] *= bfhi(a.x) * __builtin_amdgcn_rcpf(fmaxf(bfhi(b.x), 1e-30f));
                    v0[2] *= bflo(a.y) * __builtin_amdgcn_rcpf(fmaxf(bflo(b.y), 1e-30f)); v0[3] *= bfhi(a.y) * __builtin_amdgcn_rcpf(fmaxf(bfhi(b.y), 1e-30f));
                    v1[0] *= bflo(a.z) * __builtin_amdgcn_rcpf(fmaxf(bflo(b.z), 1e-30f)); v1[1] *= bfhi(a.z) * __builtin_amdgcn_rcpf(fmaxf(bfhi(b.z), 1e-30f));
                    v1[2] *= bflo(a.w) * __builtin_amdgcn_rcpf(fmaxf(bflo(b.w), 1e-30f)); v1[3] *= bfhi(a.w) * __builtin_amdgcn_rcpf(fmaxf(bfhi(b.w), 1e-30f)); } }
    }
    __device__ __forceinline__ void operator()(const f32x4 (&acc)[2][2][4][2], const Unit& u, int wr, int wc, int fr, int fq) const {
        const int row0 = u.pm * BM + wr * 64 + fr, col0 = u.pn * BM + wc * 32 + 8 * fq;
#pragma unroll
        for (int ai = 0; ai < 2; ++ai)
#pragma unroll
            for (int m = 0; m < 4; ++m) { const size_t row = (size_t)(row0 + ai * HALF + m * 16);
#pragma unroll
                for (int bj = 0; bj < 2; ++bj) { const int c = col0 + bj * HALF;
                    const u32x4 gw = *(const u32x4*)(gg + row * DINP + c);
                    f32x4 v0 = acc[ai][bj][m][0], v1 = acc[ai][bj][m][1];
                    v0[0] *= bflo(gw.x); v0[1] *= bfhi(gw.x); v0[2] *= bflo(gw.y); v0[3] *= bfhi(gw.y);
                    v1[0] *= bflo(gw.z); v1[1] *= bfhi(gw.z); v1[2] *= bflo(gw.w); v1[3] *= bfhi(gw.w);
                    *(u32x4*)(MG + row * D + c) = pack8(v0, v1); } }
    }
};
template <bool ACCUM> struct EpiGate {
    static constexpr bool PERM = true;
    bf16_t* MG; const bf16_t* gate;
    __device__ __forceinline__ void operator()(const f32x4 (&acc)[2][2][4][2], const Unit& u, int wr, int wc, int fr, int fq) const {
        const int row0 = u.pm * BM + wr * 64 + fr, col0 = u.pn * BM + wc * 32 + 8 * fq;
#pragma unroll
        for (int ai = 0; ai < 2; ++ai)
#pragma unroll
            for (int m = 0; m < 4; ++m) { const size_t row = (size_t)(row0 + ai * HALF + m * 16);
#pragma unroll
                for (int bj = 0; bj < 2; ++bj) { const int c = col0 + bj * HALF;
                    const u32x4 gw = *(const u32x4*)(gate + row * DINP + c);
                    f32x4 v0 = acc[ai][bj][m][0], v1 = acc[ai][bj][m][1];
                    v0[0] *= bflo(gw.x); v0[1] *= bfhi(gw.x); v0[2] *= bflo(gw.y); v0[3] *= bfhi(gw.y);
                    v1[0] *= bflo(gw.z); v1[1] *= bfhi(gw.z); v1[2] *= bflo(gw.w); v1[3] *= bfhi(gw.w);
                    if (ACCUM) { const u32x4 ow = *(const u32x4*)(MG + row * D + c);
                        v0[0] += bflo(ow.x); v0[1] += bfhi(ow.x); v0[2] += bflo(ow.y); v0[3] += bfhi(ow.y);
                        v1[0] += bflo(ow.z); v1[1] += bfhi(ow.z); v1[2] += bflo(ow.w); v1[3] += bfhi(ow.w); }
                    *(u32x4*)(MG + row * D + c) = pack8(v0, v1); } }
    }
};
struct EpiRes {
    static constexpr bool PERM = true;
    bf16_t* XR; const float* modv;
    __device__ __forceinline__ void operator()(const f32x4 (&acc)[2][2][4][2], const Unit& u, int wr, int wc, int fr, int fq) const {
        const int row0 = u.pm * BM + wr * 64 + fr, col0 = u.pn * BM + wc * 32 + 8 * fq;
        const int tp = u.pm % PPB, v = tp == 0 ? 4 : u.pm / PPB; const float* gp = modv + (size_t)v * 6 * D + col0;
        f32x4 gv[2][2];
#pragma unroll
        for (int bj = 0; bj < 2; ++bj)
#pragma unroll
            for (int n = 0; n < 2; ++n) gv[bj][n] = *(const f32x4*)(gp + bj * HALF + n * 4);
#pragma unroll
        for (int ai = 0; ai < 2; ++ai)
#pragma unroll
            for (int m = 0; m < 4; ++m) { bf16_t* rowp = XR + (size_t)(row0 + ai * HALF + m * 16) * D + col0;
#pragma unroll
                for (int bj = 0; bj < 2; ++bj) { u32x4* p = (u32x4*)(rowp + bj * HALF); const u32x4 w = *p;
                    const f32x4 v0 = bf4((u32x2){w.x, w.y}) + gv[bj][0] * acc[ai][bj][m][0], v1 = bf4((u32x2){w.z, w.w}) + gv[bj][1] * acc[ai][bj][m][1];
                    *p = pack8(v0, v1); } }
    }
};
struct EpiSwiglu {
    static constexpr bool PERM = true;
    bf16_t* HH; int ldc; int prow_off;
    __device__ __forceinline__ void operator()(const f32x4 (&acc)[2][2][4][2], const Unit& u, int wr, int wc, int fr, int fq) const {
        const int row0 = (u.pm - prow_off) * BM + wr * 64 + fr, col0 = u.pn * HALF + wc * 32 + 8 * fq;
#pragma unroll
        for (int ai = 0; ai < 2; ++ai)
#pragma unroll
            for (int m = 0; m < 4; ++m) { f32x4 o[2];
#pragma unroll
                for (int n = 0; n < 2; ++n)
#pragma unroll
                    for (int q = 0; q < 4; ++q) { const float a1 = acc[ai][0][m][n][q], a3 = acc[ai][1][m][n][q]; o[n][q] = a1 * fast_sigmoid(a1) * a3; }
                *(u32x4*)(HH + (size_t)(row0 + ai * HALF + m * 16) * ldc + col0) = pack8(o[0], o[1]); }
    }
};
}

namespace att {
constexpr int NW = 8, QBLK = 32, KVBLK = 64;
__device__ __forceinline__ int crow(int r, int hi) { return (r & 3) + 8 * (r >> 2) + 4 * hi; }
#define SBAR() __builtin_amdgcn_sched_barrier(0)
template <int DK> struct Cfg { static constexpr int KSTR = DK * 2 + 16, KB = KVBLK * KSTR, VB = KVBLK * 64 * 2, NQ = DK / 16, NKL = DK / 64 + (DK % 64 ? 1 : 0);
    static constexpr int OFF_V = 0, OFF_K = 2 * VB, OFF_WS = 2 * VB + 2 * KB, BYTES = OFF_WS + NW * 64 * 4; };

__device__ __forceinline__ void partialSM(f32x16& p0, f32x16& p1, float& m_reg, float& alpha, float C, float thr_raw) {
    float pmax = p0[0];
#pragma unroll
    for (int r = 1; r < 16; ++r) pmax = fmaxf(pmax, p0[r]);
#pragma unroll
    for (int r = 0; r < 16; ++r) pmax = fmaxf(pmax, p1[r]);
    { auto rr = __builtin_amdgcn_permlane32_swap(__float_as_uint(pmax), __float_as_uint(pmax), false, false);
      pmax = fmaxf(__uint_as_float(rr[0]), __uint_as_float(rr[1])); }
    float mn;
    if (__builtin_expect(__all(pmax - m_reg <= thr_raw), 1)) { mn = m_reg; alpha = 1.f; }
    else { mn = fmaxf(m_reg, pmax); alpha = __builtin_amdgcn_exp2f((m_reg - mn) * C); m_reg = mn; }
    const float mnC = -mn * C;
#pragma unroll
    for (int r = 0; r < 16; ++r) p0[r] = fmaf(p0[r], C, mnC);
#pragma unroll
    for (int r = 0; r < 16; ++r) p1[r] = fmaf(p1[r], C, mnC);
#pragma unroll
    for (int r = 0; r < 16; ++r) p0[r] = __builtin_amdgcn_exp2f(p0[r]);
}
__device__ __forceinline__ void finishSM(f32x16& p0, f32x16& p1, float alpha, float& l_reg, bf16x8& pa0, bf16x8& pa1, bf16x8& pa2, bf16x8& pa3) {
#pragma unroll
    for (int r = 0; r < 16; ++r) p1[r] = __builtin_amdgcn_exp2f(p1[r]);
    float ps = 0;
#pragma unroll
    for (int r = 0; r < 16; ++r) ps += p0[r];
#pragma unroll
    for (int r = 0; r < 16; ++r) ps += p1[r];
    { auto rr = __builtin_amdgcn_permlane32_swap(__float_as_uint(ps), __float_as_uint(ps), false, false);
      ps = __uint_as_float(rr[0]) + __uint_as_float(rr[1]); }
    l_reg = l_reg * alpha + ps;
#define PK4(P, BASE, OUT) do { unsigned a0 = cvt_pk_bf16(P[BASE + 0], P[BASE + 1]), a1 = cvt_pk_bf16(P[BASE + 2], P[BASE + 3]);   \
    unsigned b0 = cvt_pk_bf16(P[BASE + 4], P[BASE + 5]), b1 = cvt_pk_bf16(P[BASE + 6], P[BASE + 7]);                              \
    auto r0 = __builtin_amdgcn_permlane32_swap(a0, b0, false, false); auto r1 = __builtin_amdgcn_permlane32_swap(a1, b1, false, false); \
    u32x4 w = {r0[0], r1[0], r0[1], r1[1]}; OUT = __builtin_bit_cast(bf16x8, w); } while (0)
    PK4(p0, 0, pa0); PK4(p0, 8, pa1); PK4(p1, 0, pa2); PK4(p1, 8, pa3);
#undef PK4
}
template <int DK> __device__ __forceinline__ void qkt(f32x16& p0, f32x16& p1, const LAS char* Ks, const bf16x8* qr, int r32, int hi) {
    p0 = f32x16{}; p1 = f32x16{};
    const LAS char* k0 = Ks + r32 * Cfg<DK>::KSTR + hi * 16;
#pragma unroll
    for (int d0 = 0; d0 < Cfg<DK>::NQ; ++d0) {
        const bf16x8 b0 = *(const LAS bf16x8*)(k0 + d0 * 32);
        const bf16x8 b1 = *(const LAS bf16x8*)(k0 + 32 * Cfg<DK>::KSTR + d0 * 32);
        p0 = __builtin_amdgcn_mfma_f32_32x32x16_bf16(b0, qr[d0], p0, 0, 0, 0);
        p1 = __builtin_amdgcn_mfma_f32_32x32x16_bf16(b1, qr[d0], p1, 0, 0, 0); }
}
__device__ __forceinline__ int v_st(int k, int c) { const int kk = (k & ~0xC) | ((k & 4) << 1) | ((k & 8) >> 1); return ((kk >> 3) * 2 + (c >> 5)) * 512 + ((kk & 7) * 32 + (c & 31)) * 2; }
__device__ __forceinline__ int v_rd_base(int lane) { return ((lane & 3) << 3) | (((lane >> 2) & 3) << 6) | (((lane >> 4) & 1) << 5) | (((lane >> 5) & 1) << 8); }
constexpr int v_rd_off(int d0, int ks, int half) { return d0 * 512 + ks * 2048 + half * 1024; }
template <int OFF> __device__ __forceinline__ s16x4 tr_read(int vb) {
    s16x4 r; asm volatile("ds_read_b64_tr_b16 %0, %1 offset:%2" : "=&v"(r) : "v"(vb), "i"(OFF) : "memory"); return r;
}
template <int D0> __device__ __forceinline__ void pv_one(f32x16& od, int vb, bf16x8 pa0, bf16x8 pa1, bf16x8 pa2, bf16x8 pa3) {
    const s16x4 l0 = tr_read<v_rd_off(D0, 0, 0)>(vb), h0 = tr_read<v_rd_off(D0, 0, 1)>(vb), l1 = tr_read<v_rd_off(D0, 1, 0)>(vb), h1 = tr_read<v_rd_off(D0, 1, 1)>(vb);
    const s16x4 l2 = tr_read<v_rd_off(D0, 2, 0)>(vb), h2 = tr_read<v_rd_off(D0, 2, 1)>(vb), l3 = tr_read<v_rd_off(D0, 3, 0)>(vb), h3 = tr_read<v_rd_off(D0, 3, 1)>(vb);
    asm volatile("s_waitcnt lgkmcnt(0)" ::: "memory"); SBAR();
#define PK(L, H) (bf16x8){L[0], L[1], L[2], L[3], H[0], H[1], H[2], H[3]}
    od = __builtin_amdgcn_mfma_f32_32x32x16_bf16(pa0, PK(l0, h0), od, 0, 0, 0);
    od = __builtin_amdgcn_mfma_f32_32x32x16_bf16(pa1, PK(l1, h1), od, 0, 0, 0);
    od = __builtin_amdgcn_mfma_f32_32x32x16_bf16(pa2, PK(l2, h2), od, 0, 0, 0);
    od = __builtin_amdgcn_mfma_f32_32x32x16_bf16(pa3, PK(l3, h3), od, 0, 0, 0);
#undef PK
}
__device__ __forceinline__ void pv_all(f32x16* o, int vb, bf16x8 pa0, bf16x8 pa1, bf16x8 pa2, bf16x8 pa3) {
    pv_one<0>(o[0], vb, pa0, pa1, pa2, pa3); pv_one<1>(o[1], vb, pa0, pa1, pa2, pa3);
}

template <int DK>
__device__ __forceinline__ void attn_unit(const bf16_t* __restrict__ Qb, int ldq, const bf16_t* __restrict__ Kh, int ldk, const bf16_t* __restrict__ Vh, int ldv,
                                          bf16_t* __restrict__ Ob, int ldo, int NT, float C, float thr_raw, LAS char* lds, const int tid) {
    using CF = Cfg<DK>;
    const int wid = tid >> 6, lane = tid & 63, r32 = lane & 31, hi = lane >> 5;
    LAS char* V_lds = lds + CF::OFF_V; LAS char* K_lds = lds + CF::OFF_K;
    LAS float* ws = (LAS float*)(lds + CF::OFF_WS) + wid * 64; LAS float* li_l = ws; LAS float* al_l = ws + 32;
    float m_reg = -1e30f, l_reg = 0; f32x16 o[2] = {}; bf16x8 qr[CF::NQ];
    const bf16_t* Qw = Qb + (size_t)(wid * QBLK + r32) * ldq + hi * 8;
#pragma unroll
    for (int d0 = 0; d0 < CF::NQ; ++d0) qr[d0] = *(const bf16x8*)(Qw + d0 * 16);
    constexpr int CPR = DK / 8;
    const int vrow = tid >> 3, vcol = (tid & 7) * 8, vst = v_st(vrow, vcol);
    const int kid0 = tid, kid1 = 512 + (tid & 255);
    const int kr0 = kid0 / CPR, kc0 = kid0 % CPR, kr1 = kid1 / CPR, kc1 = kid1 % CPR;
    const int kst0 = kr0 * CF::KSTR + kc0 * 16, kst1 = kr1 * CF::KSTR + kc1 * 16;
    const int vb0 = (int)(uintptr_t)V_lds + v_rd_base(lane);
    bf16x8 sv[2], sk0[2], sk1[2];
#define SLOAD(i, k0) do { sv[i] = *(const bf16x8*)(Vh + (size_t)((k0) + vrow) * ldv + vcol); \
    sk0[i] = *(const bf16x8*)(Kh + (size_t)((k0) + kr0) * ldk + kc0 * 8); \
    if (DK == 96) sk1[i] = *(const bf16x8*)(Kh + (size_t)((k0) + kr1) * ldk + kc1 * 8); } while (0)
#define SWRITE(b, i) do { *(LAS bf16x8*)(V_lds + (b) * CF::VB + vst) = sv[i]; *(LAS bf16x8*)(K_lds + (b) * CF::KB + kst0) = sk0[i]; \
    if (DK == 96) *(LAS bf16x8*)(K_lds + (b) * CF::KB + kst1) = sk1[i]; } while (0)
#define SWAIT() do { if (DK == 96) asm volatile("s_waitcnt vmcnt(3)" ::: "memory"); else asm volatile("s_waitcnt vmcnt(2)" ::: "memory"); } while (0)
#define RESC(a) do { if (__any((a) < 1.f)) { if (hi == 0) al_l[r32] = (a); asm volatile("s_waitcnt lgkmcnt(0)" ::: "memory"); \
    _Pragma("unroll") for (int d = 0; d < 2; ++d) _Pragma("unroll") for (int r = 0; r < 16; ++r) o[d][r] *= al_l[crow(r, hi)]; } } while (0)
    f32x16 pA0, pA1, pB0, pB1; float alA, alB; bf16x8 pa0, pa1, pa2, pa3;
    __syncthreads();
    SLOAD(0, 0); asm volatile("s_waitcnt vmcnt(0)" ::: "memory"); SWRITE(0, 0); __syncthreads();
    qkt<DK>(pA0, pA1, K_lds, qr, r32, hi); partialSM(pA0, pA1, m_reg, alA, C, thr_raw);
    SLOAD(1, KVBLK); if (2 < NT) SLOAD(0, 2 * KVBLK);
    SWAIT(); SWRITE(1, 1); __syncthreads();
    for (int j = 1; j + 1 < NT; j += 2) {
        SBAR(); qkt<DK>(pB0, pB1, K_lds + CF::KB, qr, r32, hi);
        finishSM(pA0, pA1, alA, l_reg, pa0, pa1, pa2, pa3); SBAR();
        SLOAD(1, (j + 2) * KVBLK); SBAR();
        pv_all(o, vb0, pa0, pa1, pa2, pa3); partialSM(pB0, pB1, m_reg, alB, C, thr_raw);
        __syncthreads(); SWAIT(); SWRITE(0, 0);
        RESC(alB); __syncthreads();
        SBAR(); qkt<DK>(pA0, pA1, K_lds, qr, r32, hi);
        finishSM(pB0, pB1, alB, l_reg, pa0, pa1, pa2, pa3); SBAR();
        if (j + 3 < NT) SLOAD(0, (j + 3) * KVBLK); SBAR();
        pv_all(o, vb0 + CF::VB, pa0, pa1, pa2, pa3); partialSM(pA0, pA1, m_reg, alA, C, thr_raw);
        __syncthreads(); SWAIT(); SWRITE(1, 1);
        RESC(alA); __syncthreads();
    }
    SBAR(); qkt<DK>(pB0, pB1, K_lds + CF::KB, qr, r32, hi);
    finishSM(pA0, pA1, alA, l_reg, pa0, pa1, pa2, pa3); SBAR();
    pv_all(o, vb0, pa0, pa1, pa2, pa3); partialSM(pB0, pB1, m_reg, alB, C, thr_raw);
    __syncthreads(); RESC(alB);
    finishSM(pB0, pB1, alB, l_reg, pa0, pa1, pa2, pa3); SBAR();
    pv_all(o, vb0 + CF::VB, pa0, pa1, pa2, pa3);
    if (hi == 0) li_l[r32] = l_reg; asm volatile("s_waitcnt lgkmcnt(0)" ::: "memory");
    float rli[16];
#pragma unroll
    for (int r = 0; r < 16; ++r) rli[r] = __builtin_amdgcn_rcpf(li_l[crow(r, hi)]);
    bf16_t* Ow = Ob + (size_t)(wid * QBLK) * ldo;
#pragma unroll
    for (int r = 0; r < 16; ++r) { const int orow = crow(r, hi);
#pragma unroll
        for (int d0 = 0; d0 < 2; ++d0) Ow[(size_t)orow * ldo + d0 * 32 + r32] = (bf16_t)(cvt_pk_bf16(o[d0][r] * rli[r], 0.f) & 0xffffu); }
#undef SLOAD
#undef SWRITE
#undef SWAIT
#undef RESC
}
#undef SBAR
}


namespace att2 {
constexpr int NW = 8, QBLK = 32, KVBLK = 64, NSLOT = 3, VSLOTB = 8192;
template <int DK> struct LL { static constexpr int NQ = DK / 16, KSLOTB = DK * 128, LDS_K = 0, LDS_V = NSLOT * KSLOTB, LDS_WS = LDS_V + NSLOT * VSLOTB, LDS_OST = LDS_WS + NW * 64 * 4, BYTES = LDS_OST + NW * 4096; };
__device__ __forceinline__ int crow(int r, int hi) { return (r & 3) + 8 * (r >> 2) + 4 * hi; }
#define SBAR() __builtin_amdgcn_sched_barrier(0)
__device__ __forceinline__ void glds16(const void* gsrc, unsigned lds_dst) { unsigned keep;
    asm volatile("s_mov_b32 %0, m0\n\ts_mov_b32 m0, %2\n\ts_nop 0\n\tglobal_load_lds_dwordx4 %1, off\n\ts_mov_b32 m0, %0" : "=&s"(keep) : "v"(gsrc), "s"(lds_dst) : "memory"); }
typedef __bf16 bf16x2_t __attribute__((ext_vector_type(2)));
__device__ __forceinline__ unsigned cvtpk_s(float lo, float hi) { f32x2 v = {lo, hi}; bf16x2_t b = __builtin_convertvector(v, bf16x2_t); return __builtin_bit_cast(unsigned, b); }
#define WAIT_BAR(N) asm volatile("s_waitcnt vmcnt(" #N ") lgkmcnt(0)\n\ts_barrier" ::: "memory")
typedef LAS const char* lds_cptr;
typedef short v4i16_t __attribute__((ext_vector_type(4)));
__device__ __forceinline__ void kload2(bf16x8* kf, lds_cptr kp, int j) { kf[2 * j] = *(const LAS bf16x8*)(kp + j * 2048); kf[2 * j + 1] = *(const LAS bf16x8*)(kp + j * 2048 + 512); }
__device__ __forceinline__ s16x4 vtr(lds_cptr p) { return __builtin_bit_cast(s16x4, __builtin_amdgcn_ds_read_tr16_b64_v4i16((LAS v4i16_t*)p)); }

template <int DK>
__device__ __forceinline__ bool attn_unit(const bf16_t* Qb, int ldq, const bf16_t* __restrict__ Kh, int ldk, const bf16_t* __restrict__ Vh, int ldv, bf16_t* Ob, int ldo, int NT, LAS char* shm, int tid) {
    using L = LL<DK>; constexpr int NQ = L::NQ, KSLOTB = L::KSLOTB;
    const int lane = tid & 63, r32 = lane & 31, hi = lane >> 5; const int wid = __builtin_amdgcn_readfirstlane(tid >> 6);
    const bf16_t* Qw = Qb + (long)(wid * QBLK) * ldq;
    const unsigned lds0 = (unsigned)(uintptr_t)shm;
    LAS float* wsf = (LAS float*)(shm + L::LDS_WS) + wid * 64;
    const bf16_t* ksrc = Kh + (long)lane * ldk + wid * 8;
    const bf16_t* ksrc2 = Kh + (long)((wid & 1) * 32 + r32) * ldk + 64 + (wid >> 1) * 8;
    const bf16_t* vsrc = Vh + (long)(16 * (wid & 3) + (lane >> 2)) * ldv + (wid >> 2) * 32 + (lane & 3) * 8;
    const unsigned kdst = lds0 + L::LDS_K + wid * 1024, kdst2 = lds0 + L::LDS_K + (8 + (wid >> 1)) * 1024 + (wid & 1) * 512, vdst = lds0 + L::LDS_V + wid * 1024;
#define DMA_K(t, ks) do { glds16(ksrc + (long)(t) * KVBLK * ldk, (unsigned)__builtin_amdgcn_readfirstlane(kdst + (ks))); \
        if (DK == 96) { if (hi == 0) glds16(ksrc2 + (long)(t) * KVBLK * ldk, (unsigned)__builtin_amdgcn_readfirstlane(kdst2 + (ks))); } } while (0)
#define DMA_V(t, vs) glds16(vsrc + (long)(t) * KVBLK * ldv, (unsigned)__builtin_amdgcn_readfirstlane(vdst + (vs)))
#define WAIT_NV() do { if (DK == 96) WAIT_BAR(3); else WAIT_BAR(2); } while (0)
    const lds_cptr shm3 = (lds_cptr)shm; const lds_cptr kp0 = shm3 + L::LDS_K + hi * 1024 + r32 * 16;
    const lds_cptr vp0 = shm3 + L::LDS_V + ((lane >> 4) & 1) * 32 + (lane & 3) * 8 + (4 * hi + ((lane & 15) >> 2)) * 64;
    bf16x8 kf[2 * NQ];
    DMA_K(0, 0); DMA_V(0, 0); DMA_K(1, KSLOTB);
    bf16x8 qr[NQ];
#pragma unroll
    for (int d0 = 0; d0 < NQ; ++d0) qr[d0] = *(const bf16x8*)(Qw + (long)r32 * ldq + d0 * 16 + hi * 8);
    float l_reg = 0.f; f32x16 o[2]; o[0] = f32x16{}; o[1] = f32x16{};
    f32x16 pA0, pA1, pB0, pB1;
    int ks_prev = 0, ks_cur = 0, ks_next = KSLOTB, vs_prev = 0, vs_cur = 0, vs_next = VSLOTB;
#define ROT() do { ks_prev = ks_cur; ks_cur = ks_next; ks_next = (ks_next == (NSLOT - 1) * KSLOTB) ? 0 : ks_next + KSLOTB; \
                   vs_prev = vs_cur; vs_cur = vs_next; vs_next = (vs_next == (NSLOT - 1) * VSLOTB) ? 0 : vs_next + VSLOTB; } while (0)
    DMA_K(2, 2 * KSLOTB);
    if (DK == 96) WAIT_BAR(5); else WAIT_BAR(3);
    { pA0 = f32x16{}; pA1 = f32x16{};
#pragma unroll
      for (int d0 = 0; d0 < NQ; ++d0) { const bf16x8 b0 = *(const LAS bf16x8*)(kp0 + d0 * 2048), b1 = *(const LAS bf16x8*)(kp0 + d0 * 2048 + 512);
          pA0 = __builtin_amdgcn_mfma_f32_32x32x16_bf16(b0, qr[d0], pA0, 0, 0, 0); pA1 = __builtin_amdgcn_mfma_f32_32x32x16_bf16(b1, qr[d0], pA1, 0, 0, 0); }
#pragma unroll
      for (int r = 0; r < 16; ++r) pA0[r] = __builtin_amdgcn_exp2f(pA0[r]);
#pragma unroll
      for (int r = 0; r < 16; ++r) pA1[r] = __builtin_amdgcn_exp2f(pA1[r]); }
    WAIT_BAR(0);
    DMA_K(3, 0); DMA_V(1, VSLOTB);
    ROT();
#pragma unroll
    for (int j = 0; j < NQ; ++j) kload2(kf, kp0 + ks_cur, j);
    WAIT_NV();
    s16x4 vlo[8], vhi[8]; u32x4 pw0, pw1, pw2, pw3;
#define PKW(P, B) cvtpk_s(P[B], P[B + 1])
#define PAF(k) __builtin_bit_cast(bf16x8, pw##k)
#define VFR(i) (bf16x8){vlo[i][0], vlo[i][1], vlo[i][2], vlo[i][3], vhi[i][0], vhi[i][1], vhi[i][2], vhi[i][3]}
#define PIN(x) asm volatile("" : "+v"(x))
#define GAPA(MF, A0, A1, A2, A3, W0, W1, PW) do { MF; sacc += A0; sacc += A1; sacc += A2; sacc += A3; PIN(sacc); W0; W1; PIN(PW); SBAR(); } while (0)
#define EX(v) __builtin_amdgcn_exp2f(v)
#define GAPB(MF, X, B) do { MF; X[B] = EX(X[B]); X[B + 1] = EX(X[B + 1]); X[B + 2] = EX(X[B + 2]); X[B + 3] = EX(X[B + 3]); PIN(X); SBAR(); } while (0)
#define VRD(i) do { vlo[i] = vtr(vp_ + (((i) >> 2) * 4096 + ((i) & 3) * 1024)); vhi[i] = vtr(vp_ + (((i) >> 2) * 4096 + ((i) & 3) * 1024 + 512)); } while (0)
#define KRD(G, j) do { if (G) { kload2(kf, kp0 + ks_next, j); SBAR(); } } while (0)
#define MF32 __builtin_amdgcn_mfma_f32_32x32x16_bf16
    const f32x16 Z16 = f32x16{};
#define STEP(C0, C1, P0, P1, t, GK, GV, GL) do { SBAR(); \
    const lds_cptr vp_ = vp0 + vs_prev; \
    VRD(0); SBAR(); float sacc = (P0[0] + P0[1]); \
    GAPA(C0 = MF32(kf[0], qr[0], Z16, 0, 0, 0), P0[2], P0[3], P0[4], P0[5],     pw0[0] = PKW(P0, 0), pw0[1] = PKW(P0, 2), pw0); \
    VRD(4); SBAR(); GAPA(C1 = MF32(kf[1], qr[0], Z16, 0, 0, 0), P0[6], P0[7], P0[8], P0[9],     pw0[2] = PKW(P0, 4), pw0[3] = PKW(P0, 6), pw0); \
    VRD(1); SBAR(); GAPA(C0 = MF32(kf[2], qr[1], C0, 0, 0, 0),   P0[10], P0[11], P0[12], P0[13], pw1[0] = PKW(P0, 8), pw1[1] = PKW(P0, 10), pw1); \
    VRD(5); SBAR(); GAPA(C1 = MF32(kf[3], qr[1], C1, 0, 0, 0),   P0[14], P0[15], P1[0], P1[1],   pw1[2] = PKW(P0, 12), pw1[3] = PKW(P0, 14), pw1); \
    VRD(2); SBAR(); GAPA(C0 = MF32(kf[4], qr[2], C0, 0, 0, 0),   P1[2], P1[3], P1[4], P1[5],     pw2[0] = PKW(P1, 0), pw2[1] = PKW(P1, 2), pw2); \
    VRD(6); SBAR(); GAPA(C1 = MF32(kf[5], qr[2], C1, 0, 0, 0),   P1[6], P1[7], P1[8], P1[9],     pw2[2] = PKW(P1, 4), pw2[3] = PKW(P1, 6), pw2); \
    VRD(3); SBAR(); GAPA(C0 = MF32(kf[6], qr[3], C0, 0, 0, 0),   P1[10], P1[11], P1[12], P1[13], pw3[0] = PKW(P1, 8), pw3[1] = PKW(P1, 10), pw3); \
    VRD(7); SBAR(); GAPA(C1 = MF32(kf[7], qr[3], C1, 0, 0, 0),   P1[14], P1[15], 0.f, 0.f,       pw3[2] = PKW(P1, 12), pw3[3] = PKW(P1, 14), pw3); \
    if constexpr (DK == 96) { C0 = MF32(kf[8], qr[4], C0, 0, 0, 0); C1 = MF32(kf[9], qr[4], C1, 0, 0, 0); C0 = MF32(kf[10], qr[5], C0, 0, 0, 0); C1 = MF32(kf[11], qr[5], C1, 0, 0, 0); SBAR(); } \
    l_reg += sacc; \
    if (GK) { DMA_K((t) + 3, ks_cur); } if (GV) { DMA_V((t) + 1, vs_next); } \
    SBAR(); \
    GAPB(o[0] = MF32(PAF(0), VFR(0), o[0], 0, 0, 0), C0, 0); \
    GAPB(o[1] = MF32(PAF(0), VFR(4), o[1], 0, 0, 0), C0, 4); \
    KRD(GL, 0); GAPB(o[0] = MF32(PAF(1), VFR(1), o[0], 0, 0, 0), C0, 8); \
    KRD(GL, 1); GAPB(o[1] = MF32(PAF(1), VFR(5), o[1], 0, 0, 0), C0, 12); \
    KRD(GL, 2); GAPB(o[0] = MF32(PAF(2), VFR(2), o[0], 0, 0, 0), C1, 0); \
    KRD(GL, 3); GAPB(o[1] = MF32(PAF(2), VFR(6), o[1], 0, 0, 0), C1, 4); \
    if constexpr (DK == 96) { KRD(GL, 4); } GAPB(o[0] = MF32(PAF(3), VFR(3), o[0], 0, 0, 0), C1, 8); \
    if constexpr (DK == 96) { KRD(GL, 5); } GAPB(o[1] = MF32(PAF(3), VFR(7), o[1], 0, 0, 0), C1, 12); \
    } while (0)
    int t = 1;
    for (; t + 5 < NT; t += 2) {
        STEP(pB0, pB1, pA0, pA1, t, true, true, true);     WAIT_NV(); ROT();
        STEP(pA0, pA1, pB0, pB1, t + 1, true, true, true); WAIT_NV(); ROT();
    }
#define ENDW(tt) do { if ((tt) + 3 < NT) { WAIT_NV(); } else if ((tt) + 2 < NT) { WAIT_BAR(1); } else { WAIT_BAR(0); } } while (0)
    for (; t + 1 < NT; t += 2) {
        STEP(pB0, pB1, pA0, pA1, t, (t + 3 < NT), (t + 1 < NT), (t + 1 < NT));       ENDW(t);     ROT();
        STEP(pA0, pA1, pB0, pB1, t + 1, (t + 4 < NT), (t + 2 < NT), (t + 2 < NT));   ENDW(t + 1); ROT();
    }
    STEP(pB0, pB1, pA0, pA1, NT - 1, false, false, false);
    { float sacc = pB0[0] + pB0[1];
#pragma unroll
      for (int r = 2; r < 16; ++r) sacc += pB0[r];
#pragma unroll
      for (int r = 0; r < 16; ++r) sacc += pB1[r];
      l_reg += sacc;
      pw0 = (u32x4){PKW(pB0, 0), PKW(pB0, 2), PKW(pB0, 4), PKW(pB0, 6)}; pw1 = (u32x4){PKW(pB0, 8), PKW(pB0, 10), PKW(pB0, 12), PKW(pB0, 14)};
      pw2 = (u32x4){PKW(pB1, 0), PKW(pB1, 2), PKW(pB1, 4), PKW(pB1, 6)}; pw3 = (u32x4){PKW(pB1, 8), PKW(pB1, 10), PKW(pB1, 12), PKW(pB1, 14)};
      SBAR();
      const lds_cptr vp_ = vp0 + vs_cur;
#pragma unroll
      for (int i = 0; i < 8; ++i) VRD(i);
      o[0] = MF32(PAF(0), VFR(0), o[0], 0, 0, 0); o[0] = MF32(PAF(1), VFR(1), o[0], 0, 0, 0); o[0] = MF32(PAF(2), VFR(2), o[0], 0, 0, 0); o[0] = MF32(PAF(3), VFR(3), o[0], 0, 0, 0);
      o[1] = MF32(PAF(0), VFR(4), o[1], 0, 0, 0); o[1] = MF32(PAF(1), VFR(5), o[1], 0, 0, 0); o[1] = MF32(PAF(2), VFR(6), o[1], 0, 0, 0); o[1] = MF32(PAF(3), VFR(7), o[1], 0, 0, 0); }
    { auto rr = __builtin_amdgcn_permlane32_swap(__float_as_uint(l_reg), __float_as_uint(l_reg), false, false); l_reg = __uint_as_float(rr[0]) + __uint_as_float(rr[1]); }
    const bool bad = __any(!(l_reg > 1e-30f && l_reg < 1e30f));
    if (hi == 0) wsf[32 + r32] = l_reg; asm volatile("s_waitcnt lgkmcnt(0)" ::: "memory");
    float rli[16];
#pragma unroll
    for (int r = 0; r < 16; ++r) rli[r] = __builtin_amdgcn_rcpf(wsf[32 + crow(r, hi)]);
    bf16_t* Ow = Ob + (long)(wid * QBLK) * ldo;
    { LAS bf16_t* stg = (LAS bf16_t*)(shm + L::LDS_OST) + wid * 2048;
#pragma unroll
      for (int r = 0; r < 16; ++r) { const int orow = crow(r, hi);
#pragma unroll
          for (int d0 = 0; d0 < 2; ++d0) stg[orow * 64 + d0 * 32 + r32] = (bf16_t)(cvtpk_s(o[d0][r] * rli[r], 0.f) & 0xffffu); }
      asm volatile("s_waitcnt lgkmcnt(0)" ::: "memory");
#pragma unroll
      for (int i = 0; i < 4; ++i) { const int row = i * 8 + (lane >> 3), ch = lane & 7; const u32x4 v = *(const LAS u32x4*)(stg + row * 64 + ch * 8); *(u32x4*)(Ow + (long)row * ldo + ch * 8) = v; } }
    return bad;
#undef DMA_K
#undef DMA_V
#undef WAIT_NV
#undef ROT
#undef PKW
#undef PAF
#undef VFR
#undef PIN
#undef GAPA
#undef EX
#undef GAPB
#undef VRD
#undef KRD
#undef MF32
#undef STEP
#undef ENDW
}
#undef SBAR
#undef WAIT_BAR
}

#define XB_TMO      128
#define XB_XCNT(j)  (256  + 64 * (j))
#define XB_XSUB(j)  (1280 + 64 * (j))
#define XB_XGEN(j)  (2304 + 64 * (j))
#define XB_TOP      3328
#define XB_TOPGEN   3392
#define XCD_BAR_WORDS 3456
#define XB_SPIN_CAP (1u << 24)
__device__ __forceinline__ unsigned xb_ld(unsigned* p)              { return __hip_atomic_load(p, __ATOMIC_RELAXED, __HIP_MEMORY_SCOPE_AGENT); }
__device__ __forceinline__ unsigned xb_add(unsigned* p, unsigned v) { return __hip_atomic_fetch_add(p, v, __ATOMIC_RELAXED, __HIP_MEMORY_SCOPE_AGENT); }
__device__ __forceinline__ unsigned xb_xcc_id() { return (unsigned)__builtin_amdgcn_s_getreg((3 << 11) | 20) & 0xFu; }
#define XB_SPIN(cond, bar) do { unsigned _sp = 0; while (cond) { __builtin_amdgcn_s_sleep(1); \
    if ((++_sp & 255u) == 0u) { if (xb_ld(&(bar)[XB_TMO])) break; if (_sp > XB_SPIN_CAP) { atomicAdd(&(bar)[XB_TMO], 1u); break; } } } } while (0)
struct XcdBarrier { unsigned* bar; unsigned x; volatile LAS unsigned* st; };
__device__ __forceinline__ XcdBarrier xcd_barrier_post(unsigned* bar, volatile LAS unsigned* st) {
    XcdBarrier b; b.bar = bar; b.x = xb_xcc_id(); b.st = st;
    if (threadIdx.x == 0) (void)xb_add(&bar[XB_XCNT(b.x)], 1u);
    return b;
}
__device__ __forceinline__ void xcd_barrier_complete(unsigned* bar, unsigned x, unsigned& nloc, unsigned& nx) {
    const unsigned G = gridDim.x * gridDim.y * gridDim.z;
    unsigned sum, cnt, mine, sp = 0u;
    for (;;) {
        sum = 0u; cnt = 0u; mine = 0u;
#pragma unroll
        for (unsigned j = 0; j < 16; ++j) { const unsigned c = xb_ld(&bar[XB_XCNT(j)]); sum += c; cnt += (c > 0u) ? 1u : 0u; mine = (j == x) ? c : mine; }
        if (sum == G) break;
        __builtin_amdgcn_s_sleep(1);
        if ((++sp & 255u) == 0u) { if (xb_ld(&bar[XB_TMO])) break; if (sp > XB_SPIN_CAP) { atomicAdd(&bar[XB_TMO], 1u); break; } }
    }
    nloc = mine > 0u ? mine : 1u; nx = cnt > 0u ? cnt : 1u;
}
__device__ __forceinline__ void xcd_barrier(const XcdBarrier& b) {
    asm volatile("s_waitcnt vmcnt(0)" ::: "memory");
    __syncthreads();
    if (threadIdx.x == 0) {
        unsigned* bar = b.bar;
        __builtin_amdgcn_s_waitcnt(0);
        unsigned nloc = b.st[0], nx = b.st[1];
        if (nloc == 0u) { xcd_barrier_complete(bar, b.x, nloc, nx); b.st[0] = nloc; b.st[1] = nx; }
        const unsigned old = xb_add(&bar[XB_XSUB(b.x)], 1u);
        const unsigned gen = old / nloc;
        if (old + 1u == (gen + 1u) * nloc) {
            __builtin_amdgcn_fence(__ATOMIC_RELEASE, "agent");
            asm volatile("s_waitcnt vmcnt(0)" ::: "memory");
            const unsigned og = xb_add(&bar[XB_TOP], 1u);
            const unsigned tg = og / nx;
            if (og + 1u == (tg + 1u) * nx) xb_add(&bar[XB_TOPGEN], 1u);
            else XB_SPIN(xb_ld(&bar[XB_TOPGEN]) == tg, bar);
            __builtin_amdgcn_fence(__ATOMIC_ACQUIRE, "agent");
            xb_add(&bar[XB_XGEN(b.x)], 1u);
            asm volatile("s_waitcnt vmcnt(0)" ::: "memory");
        } else {
            XB_SPIN(xb_ld(&bar[XB_XGEN(b.x)]) == gen, bar);
            __builtin_amdgcn_fence(__ATOMIC_ACQUIRE, "agent");
            asm volatile("s_waitcnt vmcnt(0)" ::: "memory");
        }
    }
    __syncthreads();
}

struct Args {
    const float* in[26];
    float* out;
    unsigned char* ws;
    int ph_lo, ph_hi;
    float inv_mla[8];
    float inv_gqa[16];
};
enum { IN_X = 0, IN_C, IN_CTX, IN_CCTX, IN_WADA, IN_BADA, IN_N1G, IN_N2G, IN_WIN, IN_QNG, IN_WQB, IN_KVNG, IN_WKVB, IN_GQG, IN_GKG, IN_WOM, IN_WOG, IN_WOUT,
       IN_DW1, IN_DW3, IN_DW2, IN_ROUTER, IN_MW1, IN_MW3, IN_MW2, IN_FNG };

struct Ctx { int lane, wave, gw, NGW, vcu, G; LAS unsigned char* lds; };

__device__ __forceinline__ void cvt_item(const float* src, int ldw, bf16_t* dst, int K, int k0, LAS float* scr, int lane, const float* kg = nullptr) {
    if (src) {
#pragma unroll 8
        for (int i = 0; i < 32; ++i) { const int kk = 2 * i + (lane >> 5); const float gk = kg ? kg[k0 + kk] : 1.0f; scr[kk * 33 + (lane & 31)] = src[(size_t)(k0 + kk) * ldw + (lane & 31)] * gk; }
    }
    asm volatile("s_waitcnt vmcnt(0) lgkmcnt(0)" ::: "memory");
    const int c = lane & 7;
#pragma unroll
    for (int j = 0; j < 4; ++j) { const int n = (lane >> 3) + 8 * j; const LAS float* s = scr + (8 * c) * 33 + n;
        u32x4 o = (u32x4){0u, 0u, 0u, 0u};
        if (src) { o.x = cvt_pk_bf16(s[0 * 33], s[1 * 33]); o.y = cvt_pk_bf16(s[2 * 33], s[3 * 33]); o.z = cvt_pk_bf16(s[4 * 33], s[5 * 33]); o.w = cvt_pk_bf16(s[6 * 33], s[7 * 33]); }
        *(u32x4*)(dst + (size_t)n * K + k0 + 8 * c) = o; }
    asm volatile("s_waitcnt lgkmcnt(0)" ::: "memory");
}
template <int KIND>
__device__ __forceinline__ void cvt_job(const Ctx& X, int& base, int ngroups, int K, bf16_t* dst, const float* p0, const float* p1, int ldw, int gmax, const float* kg = nullptr) {
    const int nkb = K / 64, nitems = ngroups * nkb;
    LAS float* scr = (LAS float*)(X.lds + X.wave * 8448);
    int first = X.gw - (base % X.NGW); if (first < 0) first += X.NGW;
    for (int it = first; it < nitems; it += X.NGW) {
        const int g = it / nkb, kb = it % nkb; const float* src;
        if (KIND == 0) { src = p0 + g * 32; if (g >= gmax) src = nullptr; }
        else if (KIND == 1) { const int pn = g >> 3, j = g & 7; const size_t off = (size_t)pn * 128 + (j & 3) * 32; const size_t d = (j >> 2) ? (size_t)(p1 - p0) : 0; src = p0 + d + off; }
        else if (KIND == 2) { src = g < 16 ? p0 + (g >> 1) * 96 + (g & 1) * 32 : p0 + (g - 16) * 96 + 64; }
        else {
            if (g < 21) src = p0 + g * 32;
            else if (g < 24) src = nullptr;
            else if (g < 40) { const int t = (g - 24) >> 3, j = (g - 24) & 7; src = p0 + 672 + (4 * t + (j & 3)) * 64 + 32 * (j >> 2); }
            else if (g < 48) { const int j = g - 40, wc = j & 3, bj = j >> 2; src = wc < 2 ? p0 + 1184 + wc * 64 + 32 * bj : p0 + 1312 + (wc - 2) * 64 + 32 * bj; }
            else src = p0 + 1440 + (g - 48) * 32; }
        cvt_item(src, ldw, dst + (size_t)g * 32 * K, K, kb * 64, scr, X.lane, kg);
    }
    base += nitems;
}
__device__ __forceinline__ void cvt_moe_layer(const Ctx& X, int& base, const float* mw1, const float* mw3, const float* mw2, unsigned char* ws, int li) {
    bf16_t* w13 = (bf16_t*)(ws + WS_WMOE13); bf16_t* w2 = (bf16_t*)(ws + WS_WMOE2);
    for (int e = 0; e < NE; ++e) {
        const float* w1 = mw1 + (size_t)(li * NE + e) * D * FE; const float* w3 = mw3 + (size_t)(li * NE + e) * D * FE;
        cvt_job<1>(X, base, 2 * FE / 32, D, w13 + (size_t)e * 2 * FE * D, w1, w3, FE, 1 << 30);
        const float* w2s = mw2 + (size_t)(li * NE + e) * FE * D;
        cvt_job<0>(X, base, D / 32, FE, w2 + (size_t)e * D * FE, w2s, w2s, D, 1 << 30);
    }
}
__device__ __forceinline__ void sincos_d(float ang, float& c, float& s) {
    const double a = (double)ang; const double k = __builtin_rint(a * 0.63661977236758134308); const long n = (long)k;
    const double r = (a - k * 1.57079632673412561417e+00) - k * 6.07710050650619224932e-11;
    const double r2 = r * r;
    double sp = -7.6471637318198164759e-13; sp = sp * r2 + 1.6059043836821614599e-10; sp = sp * r2 - 2.5052108385441718775e-08; sp = sp * r2 + 2.7557319223985890653e-06;
    sp = sp * r2 - 1.9841269841269841270e-04; sp = sp * r2 + 8.3333333333333333333e-03; sp = sp * r2 - 1.6666666666666666667e-01; const double sr = r + r * r2 * sp;
    double cp = 4.7794773323873852974e-14; cp = cp * r2 - 1.1470745597729724714e-11; cp = cp * r2 + 2.0876756987868098979e-09; cp = cp * r2 - 2.7557319223985890653e-07;
    cp = cp * r2 + 2.4801587301587301587e-05; cp = cp * r2 - 1.3888888888888888889e-03; cp = cp * r2 + 4.1666666666666666667e-02; const double cr = 1.0 - 0.5 * r2 + r2 * r2 * cp;
    const int q = (int)(n & 3);
    const double sv = (q == 0) ? sr : (q == 1) ? cr : (q == 2) ? -sr : -cr;
    const double cv = (q == 0) ? cr : (q == 1) ? -sr : (q == 2) ? -cr : sr;
    c = (float)cv; s = (float)sv;
}


__device__ __forceinline__ void lds_fill(LAS unsigned char* dst, const float* src, int n4, int tid) {
    for (int i = tid; i < n4; i += 512) ((LAS f32x4*)dst)[i] = ((const f32x4*)src)[i];
}
constexpr int TL_GAIN = 0, TL_MOD = 4096, TL_G2 = 4096 + 40960, TL_ROUTER = 65536, TL_ROPEM = 98304, TL_ROPEG = 106496;

template <bool FIRST, bool COMBINE>
__device__ __forceinline__ void norm1_rows(const Ctx& X, int l, bf16_t* XR, bf16_t* Hb, const bf16_t* Yg, const float* modp, const i32x2* tok_slot, const f32x2* tok_w,
                                           const float* gain, const float* xin, const float* cin, int tid) {
    const int lane = X.lane; const float* modl = modp + (size_t)l * 5 * 6 * D;
    lds_fill(X.lds + TL_GAIN, gain, D / 4, tid);
    for (int v = 0; v < 5; ++v) { lds_fill(X.lds + TL_MOD + v * 8192, modl + (size_t)v * 6 * D, 2 * D / 4, tid);
        if (COMBINE) lds_fill(X.lds + TL_G2 + v * 4096, modp + ((size_t)((l - 1) * 5 + v) * 6 + 5) * D, D / 4, tid); }
    __syncthreads();
    auto src_of = [&](int row) -> const float* { const int b = row / TPB, t = row - b * TPB;
        return t < NCTX ? cin + ((size_t)b * NCTX + t) * D : xin + ((size_t)b * SEQ + (t - NCTX)) * D; };
    f32x4 xnf[4]; u32x2 xnb[4]; i32x2 sln = (i32x2){0, 0}; f32x2 wn = (f32x2){0.f, 0.f};
    { const int row0 = X.gw < T ? X.gw : T - 1;
      if (FIRST) { const float* src = src_of(row0);
#pragma unroll
          for (int j = 0; j < 4; ++j) xnf[j] = ((const f32x4*)src)[lane + 64 * j]; }
      else {
#pragma unroll
          for (int j = 0; j < 4; ++j) xnb[j] = ((const u32x2*)(XR + (size_t)row0 * D))[lane + 64 * j]; }
      if (COMBINE) { sln = tok_slot[row0]; wn = tok_w[row0]; } }
    for (int row = X.gw; row < T; row += X.NGW) {
        const int b = row / TPB, t = row - b * TPB, v = t < NCTX ? 4 : b;
        f32x4 x[4]; const i32x2 sl = sln; const f32x2 w = wn;
#pragma unroll
        for (int j = 0; j < 4; ++j) x[j] = FIRST ? xnf[j] : bf4(xnb[j]);
        u32x2 ya[4], yb[4];
        if (COMBINE) {
#pragma unroll
            for (int j = 0; j < 4; ++j) { ya[j] = ((const u32x2*)(Yg + (size_t)sl.x * D))[lane + 64 * j]; yb[j] = ((const u32x2*)(Yg + (size_t)sl.y * D))[lane + 64 * j]; } }
        { const int nrow = row + X.NGW; if (nrow < T) {
            if (FIRST) { const float* src = src_of(nrow);
#pragma unroll
                for (int j = 0; j < 4; ++j) xnf[j] = ((const f32x4*)src)[lane + 64 * j]; }
            else {
#pragma unroll
                for (int j = 0; j < 4; ++j) xnb[j] = ((const u32x2*)(XR + (size_t)nrow * D))[lane + 64 * j]; }
            if (COMBINE) { sln = tok_slot[nrow]; wn = tok_w[nrow]; } } }
        if (COMBINE) { const LAS f32x4* g2 = (const LAS f32x4*)(X.lds + TL_G2 + v * 4096);
#pragma unroll
            for (int j = 0; j < 4; ++j) { const f32x4 g = g2[lane + 64 * j];
                x[j][0] += g[0] * (w.x * bflo(ya[j].x) + w.y * bflo(yb[j].x)); x[j][1] += g[1] * (w.x * bfhi(ya[j].x) + w.y * bfhi(yb[j].x));
                x[j][2] += g[2] * (w.x * bflo(ya[j].y) + w.y * bflo(yb[j].y)); x[j][3] += g[3] * (w.x * bfhi(ya[j].y) + w.y * bfhi(yb[j].y)); } }
        if (FIRST || COMBINE) {
#pragma unroll
            for (int j = 0; j < 4; ++j) { u32x2 o; o.x = cvt_pk_bf16(x[j][0], x[j][1]); o.y = cvt_pk_bf16(x[j][2], x[j][3]); ((u32x2*)(XR + (size_t)row * D))[lane + 64 * j] = o; } }
        float ss = 0.f;
#pragma unroll
        for (int j = 0; j < 4; ++j) ss += (x[j][0] * x[j][0] + x[j][1] * x[j][1]) + (x[j][2] * x[j][2] + x[j][3] * x[j][3]);
        const float rstd = 1.0f / sqrtf(wave_sum(ss) * (1.0f / D) + EPS);
        const LAS f32x4* gl = (const LAS f32x4*)(X.lds + TL_GAIN); const LAS f32x4* sh = (const LAS f32x4*)(X.lds + TL_MOD + v * 8192); const LAS f32x4* sc = sh + D / 4;
#pragma unroll
        for (int j = 0; j < 4; ++j) { const f32x4 g = gl[lane + 64 * j], s1 = sc[lane + 64 * j], s0 = sh[lane + 64 * j];
            const f32x4 h = (x[j] * rstd * g) * (s1 + 1.0f) + s0; u32x2 o; o.x = cvt_pk_bf16(h[0], h[1]); o.y = cvt_pk_bf16(h[2], h[3]);
            ((u32x2*)(Hb + (size_t)row * D))[lane + 64 * j] = o; }
    }
}

typedef const __attribute__((address_space(4))) Args CArgs;
__device__ __forceinline__ CArgs* get_args() { unsigned long long kp = (unsigned long long)__builtin_amdgcn_kernarg_segment_ptr(); asm volatile("" : "+s"(kp)); return (CArgs*)kp; }
__device__ __forceinline__ Ctx make_ctx(LAS unsigned char* lds, int tid, int bx, int G) {
    Ctx X; X.lds = lds; X.lane = tid & 63; X.wave = __builtin_amdgcn_readfirstlane(tid >> 6);
    X.G = G; X.vcu = (G % 8 == 0) ? (bx % 8) * (G / 8) + bx / 8 : bx;
    X.gw = X.vcu * 8 + X.wave; X.NGW = G * 8; return X;
}
#ifndef PH_MASK
#define PH_MASK 0xffffffffu
#endif
#define PH(n) (((PH_MASK) >> (n)) & 1u)

__global__ void __launch_bounds__(512, 2) mega_fwd(Args a_unused) {
    extern __shared__ __attribute__((aligned(16))) unsigned char lds_raw[];
    LAS unsigned char* const lds = (LAS unsigned char*)lds_raw;
    volatile LAS unsigned* const LC = (volatile LAS unsigned*)(lds + LDSCTL_OFF);
    for (int u = threadIdx.x; u < 128; u += 512) LC[u] = 0u;
    __syncthreads();
    int lo, hi;
    { CArgs* ap = get_args(); lo = ap->ph_lo; hi = ap->ph_hi;
      if (!MK_MULTI) { (void)xcd_barrier_post((unsigned*)(ap->ws + WS_CTL) + CW_BAR, LC); } }
    int step = 0;
#define STEP_ON(k) (step >= lo && step < hi && PH(k))
#define STEP_END do { if (step >= lo && step + 1 < hi) { CArgs* ap_ = get_args(); XcdBarrier b_; b_.bar = (unsigned*)(ap_->ws + WS_CTL) + CW_BAR; b_.x = xb_xcc_id(); b_.st = LC; xcd_barrier(b_); } ++step; } while (0)
#define PHASE_VARS CArgs* ap = get_args(); unsigned char* const ws = ap->ws; int tid = threadIdx.x; asm volatile("" : "+v"(tid)); int bx_ = blockIdx.x, G_ = gridDim.x; asm volatile("" : "+s"(bx_), "+s"(G_)); \
    const Ctx X = make_ctx(lds, tid, bx_, G_); const int lane = X.lane; (void)lane; (void)ws

    if (STEP_ON(0)) {
        PHASE_VARS;
        float* modp = (float*)(ws + WS_MOD); float* rope_m = (float*)(ws + WS_ROPE_MLA); float* rope_g = (float*)(ws + WS_ROPE_GQA);
        LAS float* sl = (LAS float*)(lds + 73728);
        { const float* cin = ap->in[IN_C]; const float* ccin = ap->in[IN_CCTX];
          for (int i = tid; i < 5 * D; i += 512) { const int v = i / D, k = i % D; const float c = v < 4 ? cin[v * D + k] : ccin[k]; sl[i] = c / (1.0f + __expf(-c)); } }
        __syncthreads();
        LAS float* part = (LAS float*)(lds + 73728 + 20480);
        { const float* wada = ap->in[IN_WADA]; const float* bada = ap->in[IN_BADA];
          for (int bi = X.vcu; bi < DEPTH * 96; bi += X.G) {
            const int l = bi / 96, cg = bi % 96, col = cg * 64 + lane;
            const float* wp = wada + (size_t)l * D * 6 * D + col;
            float s0 = 0.f, s1 = 0.f, s2 = 0.f, s3 = 0.f, s4 = 0.f;
#pragma unroll 16
            for (int kk = 0; kk < 128; ++kk) { const int k = X.wave * 128 + kk; const float w = wp[(size_t)k * 6 * D];
                s0 += sl[k] * w; s1 += sl[D + k] * w; s2 += sl[2 * D + k] * w; s3 += sl[3 * D + k] * w; s4 += sl[4 * D + k] * w; }
            part[(X.wave * 5 + 0) * 64 + lane] = s0; part[(X.wave * 5 + 1) * 64 + lane] = s1; part[(X.wave * 5 + 2) * 64 + lane] = s2;
            part[(X.wave * 5 + 3) * 64 + lane] = s3; part[(X.wave * 5 + 4) * 64 + lane] = s4;
            __syncthreads();
            if (tid < 320) { const int v = tid / 64, ln = tid % 64; float s = bada[l * 6 * D + cg * 64 + ln];
#pragma unroll
                for (int w = 0; w < 8; ++w) s += part[(w * 5 + v) * 64 + ln];
                modp[((size_t)(l * 5 + v) * 6) * D + cg * 64 + ln] = s; }
            __syncthreads();
          } }
        { const int gt = X.vcu * 512 + tid;
          if (gt < 128 * 8) { const int pos = gt >> 3, f = gt & 7; float c, s; sincos_d((float)pos * ap->inv_mla[f], c, s); rope_m[pos * 16 + f] = c; rope_m[pos * 16 + 8 + f] = s; }
          else if (gt < 128 * 8 + 128 * 16) { const int g2 = gt - 128 * 8, pos = g2 >> 4, f = g2 & 15; float c, s; sincos_d((float)pos * ap->inv_gqa[f], c, s); rope_g[pos * 32 + f] = c; rope_g[pos * 32 + 16 + f] = s; } }
        int base = 0;
        for (int l = 0; l < DEPTH; ++l) {
            unsigned char* wl = ws + WS_WSM + (size_t)l * LW;
            { const float* w = ap->in[IN_WIN] + (size_t)l * D * 3488; cvt_job<3>(X, base, DINP / 32, D, (bf16_t*)(wl + OFF_WIN), w, w, 3488, 1 << 30); }
            { const float* w = ap->in[IN_WQB] + (size_t)l * 384 * 768; cvt_job<2>(X, base, 24, 384, (bf16_t*)(wl + OFF_WQB), w, w, 768, 1 << 30, ap->in[IN_QNG] + l * 384); }
            { const float* w = ap->in[IN_WKVB] + (size_t)l * 256 * 1024; cvt_job<0>(X, base, 32, 256, (bf16_t*)(wl + OFF_WKVB), w, w, 1024, 1 << 30, ap->in[IN_KVNG] + l * 256); }
            { const float* w = ap->in[IN_WOM] + (size_t)l * 512 * 1024; cvt_job<0>(X, base, 32, 512, (bf16_t*)(wl + OFF_WOM), w, w, 1024, 1 << 30); }
            { const float* w = ap->in[IN_WOG] + (size_t)l * 512 * 1024; cvt_job<0>(X, base, 32, 512, (bf16_t*)(wl + OFF_WOG), w, w, 1024, 1 << 30); }
            { const float* w = ap->in[IN_WOUT] + (size_t)l * 1024 * 1024; cvt_job<0>(X, base, 32, 1024, (bf16_t*)(wl + OFF_WOUT), w, w, 1024, 1 << 30); }
        }
        for (int li = 0; li < 2; ++li) {
            unsigned char* wd = ws + WS_WDEN + (size_t)li * LWD;
            const float* w1 = ap->in[IN_DW1] + (size_t)li * D * FD; const float* w3 = ap->in[IN_DW3] + (size_t)li * D * FD; const float* w2 = ap->in[IN_DW2] + (size_t)li * FD * D;
            cvt_job<1>(X, base, 2 * FD / 32, D, (bf16_t*)wd, w1, w3, FD, 1 << 30);
            cvt_job<0>(X, base, D / 32, FD, (bf16_t*)(wd + SZ_W13D), w2, w2, D, 1 << 30);
        }
        cvt_moe_layer(X, base, ap->in[IN_MW1], ap->in[IN_MW3], ap->in[IN_MW2], ws, 0);
    }
    STEP_END;

    for (int l = 0; l < DEPTH; ++l) {
        const bool moe = (l & 1) != 0, prev_moe = l > 0 && ((l - 1) & 1) != 0; const int last = (l == DEPTH - 1) ? 1 : 0;
        if (STEP_ON(1)) {
            PHASE_VARS;
            bf16_t* XR = (bf16_t*)(ws + WS_XR); bf16_t* Hb = (bf16_t*)(ws + WS_H); const bf16_t* Yg = (const bf16_t*)(ws + WS_YG);
            const float* modp = (const float*)(ws + WS_MOD); const float* modl = modp + (size_t)l * 5 * 6 * D;
            const i32x2* tok_slot = (const i32x2*)(ws + WS_TOK_SLOT); const f32x2* tok_w = (const f32x2*)(ws + WS_TOK_W);
            const float* gain = ap->in[IN_N1G] + l * D; const float* xin = ap->in[IN_X]; const float* cin = ap->in[IN_CTX];
            if (l == 0) norm1_rows<true, false>(X, l, XR, Hb, Yg, modp, tok_slot, tok_w, gain, xin, cin, tid);
            else if (prev_moe) norm1_rows<false, true>(X, l, XR, Hb, Yg, modp, tok_slot, tok_w, gain, xin, cin, tid);
            else norm1_rows<false, false>(X, l, XR, Hb, Yg, modp, tok_slot, tok_w, gain, xin, cin, tid);
            if (l == 2) { __syncthreads(); int base = 0; cvt_moe_layer(X, base, ap->in[IN_MW1], ap->in[IN_MW3], ap->in[IN_MW2], ws, 1); }
        }
        STEP_END;
        if (STEP_ON(2)) {
            PHASE_VARS;
            pg8::Gemm g{(const bf16_t*)(ws + WS_H), (const bf16_t*)(ws + WS_WSM + (size_t)l * LW + OFF_WIN), D, D, D}; pg8::StaticOrder S{T / 256, DINP / 256, X.G, bx_};
            pg8::EpiIn E{(bf16_t*)(ws + WS_Y), (float*)(ws + WS_SSQ_Q), (float*)(ws + WS_SSQ_KV), (bf16_t*)(ws + WS_KM), (const float*)(ws + WS_ROPE_MLA), (const float*)(ws + WS_ROPE_GQA), ap->in[IN_GQG] + l * 64, ap->in[IN_GKG] + l * 64};
            pg8::gemm_phase<pg8::EpiIn, pg8::StaticOrder, true, true>(lds, g, S, E, tid);
        }
        STEP_END;
        if (STEP_ON(4)) {
            PHASE_VARS;
            const bf16_t* Yb = (const bf16_t*)(ws + WS_Y); const unsigned char* wl = ws + WS_WSM + (size_t)l * LW;
            { pg8::Gemm g{Yb + C_QC, (const bf16_t*)(wl + OFF_WQB), DINP, 384, 384}; pg8::StaticOrder S{last ? NB * 32 : T / 256, 3, X.G, bx_, last};
              pg8::EpiQ E{(bf16_t*)(ws + WS_QM), (const float*)(ws + WS_ROPE_MLA), (const float*)(ws + WS_SSQ_Q)}; pg8::gemm_phase<pg8::EpiQ, pg8::StaticOrder, true, true>(lds, g, S, E, tid); }
            { pg8::Gemm g{Yb + C_KVC, (const bf16_t*)(wl + OFF_WKVB), DINP, 256, 256}; pg8::StaticOrder S{T / 256, 4, X.G, bx_};
              pg8::EpiKV E{(bf16_t*)(ws + WS_KM), (bf16_t*)(ws + WS_VM), (const float*)(ws + WS_SSQ_KV)}; pg8::gemm_phase<pg8::EpiKV, pg8::StaticOrder, true, true>(lds, g, S, E, tid); }
        }
        STEP_END;
        if (STEP_ON(5)) {
            PHASE_VARS;
            bf16_t* Yb = (bf16_t*)(ws + WS_Y); bf16_t* Qm = (bf16_t*)(ws + WS_QM); bf16_t* Km = (bf16_t*)(ws + WS_KM); bf16_t* Vm = (bf16_t*)(ws + WS_VM);
            bf16_t* Om = (bf16_t*)(ws + WS_OM); bf16_t* Og = (bf16_t*)(ws + WS_OG);
            const float Cm = 0.10206207261596575f * LOG2E, Cg = 0.125f * LOG2E;
#define ATT_DECODE(L) \
                int b, h, q0, nt; bool gqa; \
                if (L < 2048) { const int pr = (int)(L / 256) * 8 + (int)(L % 8), qb = (int)(L / 8) % 32; q0 = NCTX + qb * 256; nt = TPB / 64; \
                    if (pr < 32) { const int x8 = pr & 7, g = pr >> 3; gqa = true; b = x8 >> 1; h = (x8 & 1) * 4 + g; } \
                    else { const int p2 = pr - 32; gqa = false; b = p2 >> 3; h = p2 & 7; } } \
                else { const int c = (int)(L - 2048); gqa = c < 32; b = (c >> 3) & 3; h = c & 7; q0 = 0; nt = NCTX / 64; } \
                const size_t r0 = (size_t)b * TPB;
            for (int i = 0;; ++i) {
                const long L = (long)i * X.G + bx_; if (L >= (last ? 2048 : 2048 + 64)) break;
                ATT_DECODE(L)
                bool bad;
                if (gqa) { const int kvh = h >> 2;
                    bad = att2::attn_unit<64>(Yb + (r0 + q0) * DINP + C_QG + h * 64, DINP, Yb + r0 * DINP + C_KG + kvh * 64, DINP, Yb + r0 * DINP + C_VG + kvh * 64, DINP,
                                              Og + (r0 + q0) * 512 + h * 64, 512, nt, (LAS char*)lds, tid);
                } else {
                    bad = att2::attn_unit<96>(Qm + (r0 + q0) * 768 + h * 96, 768, Km + r0 * 768 + h * 96, 768, Vm + r0 * 512 + h * 64, 512,
                                              Om + (r0 + q0) * 512 + h * 64, 512, nt, (LAS char*)lds, tid);
                }
                if (bad && lane == 0) __hip_atomic_fetch_or((LAS unsigned*)(LC + 60), 1u << i, __ATOMIC_RELAXED, __HIP_MEMORY_SCOPE_WORKGROUP);
                asm volatile("s_waitcnt lgkmcnt(0)\n\ts_barrier" ::: "memory");
            }
            const unsigned redo = LC[60];
            if (redo != 0u) {
                for (int i = 0; i < 32; ++i) { if (!((redo >> i) & 1u)) continue;
                    const long L = (long)i * X.G + bx_;
                    ATT_DECODE(L)
                    if (gqa) { const int kvh = h >> 2;
                        att::attn_unit<64>(Yb + (r0 + q0) * DINP + C_QG + h * 64, DINP, Yb + r0 * DINP + C_KG + kvh * 64, DINP, Yb + r0 * DINP + C_VG + kvh * 64, DINP,
                                           Og + (r0 + q0) * 512 + h * 64, 512, nt, 1.0f, 8.0f, (LAS char*)lds, tid);
                    } else {
                        att::attn_unit<96>(Qm + (r0 + q0) * 768 + h * 96, 768, Km + r0 * 768 + h * 96, 768, Vm + r0 * 512 + h * 64, 512,
                                           Om + (r0 + q0) * 512 + h * 64, 512, nt, 1.0f, 8.0f, (LAS char*)lds, tid);
                    }
                }
                __syncthreads(); if (tid == 0) LC[60] = 0u;
            }
#undef ATT_DECODE
            __syncthreads();
        }
        STEP_END;
        if (STEP_ON(6)) {
            PHASE_VARS;
            static_assert(WS_OG == WS_OM + (size_t)T * 512 * 2 && OFF_WOG == OFF_WOM + (size_t)1024 * 512 * 2, "pair layout");
            pg8::Gemm g{(const bf16_t*)(ws + WS_OM), (const bf16_t*)(ws + WS_WSM + (size_t)l * LW + OFF_WOM), 512, 512, 512}; pg8::PairOrder S{last ? NB * 32 : T / 256, 4, X.G, bx_, T / 256, 4, last};
            pg8::EpiGate2 E{(bf16_t*)(ws + WS_MG), (const bf16_t*)(ws + WS_Y) + C_GM, (const bf16_t*)(ws + WS_Y) + C_GG}; pg8::gemm_phase<pg8::EpiGate2, pg8::PairOrder, true, true>(lds, g, S, E, tid);
        }
        STEP_END;
        if (STEP_ON(8)) {
            PHASE_VARS;
            pg8::Gemm g{(const bf16_t*)(ws + WS_MG), (const bf16_t*)(ws + WS_WSM + (size_t)l * LW + OFF_WOUT), D, D, D}; pg8::StaticOrder S{last ? NB * 32 : T / 256, 4, X.G, bx_, last};
            pg8::EpiRes E{(bf16_t*)(ws + WS_XR), (const float*)(ws + WS_MOD) + (size_t)l * 5 * 6 * D + 2 * D}; pg8::gemm_phase<pg8::EpiRes, pg8::StaticOrder, true, true>(lds, g, S, E, tid);
        }
        STEP_END;
        if (STEP_ON(9)) {
            PHASE_VARS;
            const bf16_t* XR = (const bf16_t*)(ws + WS_XR); bf16_t* Hb = (bf16_t*)(ws + WS_H); const float* modl = (const float*)(ws + WS_MOD) + (size_t)l * 5 * 6 * D;
            int* cntb = (int*)(ws + WS_CNTB); unsigned* tok_e = (unsigned*)(ws + WS_TOK_E); i32x2* tok_pos = (i32x2*)(ws + WS_TOK_POS); f32x2* tok_w = (f32x2*)(ws + WS_TOK_W);
            const float* gain = ap->in[IN_N2G] + l * D; const float* router = ap->in[IN_ROUTER] + (size_t)(l >> 1) * D * NE;
            f32x4 rt[32];
            if (moe) { if (tid < 8) LC[16 + tid] = 0u;
#pragma unroll
                for (int j = 0; j < 4; ++j)
#pragma unroll
                    for (int qq = 0; qq < 8; ++qq) rt[j * 8 + qq] = ((const f32x4*)(router + (size_t)(4 * (lane + 64 * j)) * NE))[qq]; }
            else {
#pragma unroll
                for (int i = 0; i < 32; ++i) rt[i] = (f32x4){0.f, 0.f, 0.f, 0.f}; }
            lds_fill(lds + TL_GAIN, gain, D / 4, tid);
            for (int v = 0; v < 5; ++v) lds_fill(lds + TL_MOD + v * 8192, modl + ((size_t)v * 6 + 3) * D, 2 * D / 4, tid);
            __syncthreads();
            constexpr int NG = 3;
            u32x2 xn[NG][4];
#pragma unroll
            for (int q = 0; q < NG; ++q) { int r = X.gw + q * X.NGW; r = r < T ? r : T - 1;
#pragma unroll
                for (int j = 0; j < 4; ++j) xn[q][j] = ((const u32x2*)(XR + (size_t)r * D))[lane + 64 * j]; }
            for (int row0 = X.gw; row0 < T; row0 += NG * X.NGW) {
                u32x2 xc[NG][4];
#pragma unroll
                for (int q = 0; q < NG; ++q)
#pragma unroll
                    for (int j = 0; j < 4; ++j) xc[q][j] = xn[q][j];
#pragma unroll
                for (int q = 0; q < NG; ++q) { int r = row0 + (NG + q) * X.NGW; r = r < T ? r : T - 1;
#pragma unroll
                    for (int j = 0; j < 4; ++j) xn[q][j] = ((const u32x2*)(XR + (size_t)r * D))[lane + 64 * j]; }
#pragma unroll
                for (int q = 0; q < NG; ++q) {
                const int row = row0 + q * X.NGW; if (row >= T) break;
                const int b = row / TPB, t = row - b * TPB, v = t < NCTX ? 4 : b;
                if (last && t < NCTX) continue;
                f32x4 x[4]; float ss = 0.f;
#pragma unroll
                for (int j = 0; j < 4; ++j) { x[j] = bf4(xc[q][j]); ss += (x[j][0] * x[j][0] + x[j][1] * x[j][1]) + (x[j][2] * x[j][2] + x[j][3] * x[j][3]); }
                const float rstd = 1.0f / sqrtf(wave_sum(ss) * (1.0f / D) + EPS);
                const LAS f32x4* gl = (const LAS f32x4*)(lds + TL_GAIN); const LAS f32x4* sh = (const LAS f32x4*)(lds + TL_MOD + v * 8192); const LAS f32x4* sc = sh + D / 4;
                float lg0 = 0.f, lg1 = 0.f, lg2 = 0.f, lg3 = 0.f, lg4 = 0.f, lg5 = 0.f, lg6 = 0.f, lg7 = 0.f;
#pragma unroll
                for (int j = 0; j < 4; ++j) { const f32x4 g = gl[lane + 64 * j], s1 = sc[lane + 64 * j], s0 = sh[lane + 64 * j];
                    const f32x4 h = (x[j] * rstd * g) * (s1 + 1.0f) + s0; u32x2 o; o.x = cvt_pk_bf16(h[0], h[1]); o.y = cvt_pk_bf16(h[2], h[3]);
                    ((u32x2*)(Hb + (size_t)row * D))[lane + 64 * j] = o;
                    if (moe) {
#pragma unroll
                        for (int qq = 0; qq < 4; ++qq) { const f32x4 r0 = rt[j * 8 + 2 * qq], r1 = rt[j * 8 + 2 * qq + 1];
                            lg0 += h[qq] * r0[0]; lg1 += h[qq] * r0[1]; lg2 += h[qq] * r0[2]; lg3 += h[qq] * r0[3];
                            lg4 += h[qq] * r1[0]; lg5 += h[qq] * r1[1]; lg6 += h[qq] * r1[2]; lg7 += h[qq] * r1[3]; } } }
                if (moe) {
                    {
                        float t0, t1, t2, t3;
                        { auto r = __builtin_amdgcn_permlane32_swap(__float_as_uint(lg0), __float_as_uint(lg4), false, false); t0 = __uint_as_float(r[0]) + __uint_as_float(r[1]); }
                        { auto r = __builtin_amdgcn_permlane32_swap(__float_as_uint(lg1), __float_as_uint(lg5), false, false); t1 = __uint_as_float(r[0]) + __uint_as_float(r[1]); }
                        { auto r = __builtin_amdgcn_permlane32_swap(__float_as_uint(lg2), __float_as_uint(lg6), false, false); t2 = __uint_as_float(r[0]) + __uint_as_float(r[1]); }
                        { auto r = __builtin_amdgcn_permlane32_swap(__float_as_uint(lg3), __float_as_uint(lg7), false, false); t3 = __uint_as_float(r[0]) + __uint_as_float(r[1]); }
                        const bool b4 = (lane & 16) != 0, b3 = (lane & 8) != 0;
                        const float u0 = (b4 ? t2 : t0) + lane_xor<16>(b4 ? t0 : t2), u1 = (b4 ? t3 : t1) + lane_xor<16>(b4 ? t1 : t3);
                        float w = (b3 ? u1 : u0) + lane_xor<8>(b3 ? u0 : u1);
                        w += lane_xor<4>(w); w += lane_xor<2>(w); w += lane_xor<1>(w);
                        const int wi = (int)__float_as_uint(w);
                        lg0 = __uint_as_float((unsigned)__builtin_amdgcn_readlane(wi, 0));  lg1 = __uint_as_float((unsigned)__builtin_amdgcn_readlane(wi, 8));
                        lg2 = __uint_as_float((unsigned)__builtin_amdgcn_readlane(wi, 16)); lg3 = __uint_as_float((unsigned)__builtin_amdgcn_readlane(wi, 24));
                        lg4 = __uint_as_float((unsigned)__builtin_amdgcn_readlane(wi, 32)); lg5 = __uint_as_float((unsigned)__builtin_amdgcn_readlane(wi, 40));
                        lg6 = __uint_as_float((unsigned)__builtin_amdgcn_readlane(wi, 48)); lg7 = __uint_as_float((unsigned)__builtin_amdgcn_readlane(wi, 56));
                    }
                    float v1 = lg0; int i1 = 0;
#define TOP1(e, x_) if (x_ > v1) { v1 = x_; i1 = e; }
                    TOP1(1, lg1) TOP1(2, lg2) TOP1(3, lg3) TOP1(4, lg4) TOP1(5, lg5) TOP1(6, lg6) TOP1(7, lg7)
#undef TOP1
                    float v2 = -INFINITY; int i2 = 0;
#define TOP2(e, x_) if (i1 != e && x_ > v2) { v2 = x_; i2 = e; }
                    TOP2(0, lg0) TOP2(1, lg1) TOP2(2, lg2) TOP2(3, lg3) TOP2(4, lg4) TOP2(5, lg5) TOP2(6, lg6) TOP2(7, lg7)
#undef TOP2
                    const float ex = __expf(v2 - v1), w1 = 1.0f / (1.0f + ex), w2 = ex * w1;
                    if (lane == 0) { const int pa = (int)__hip_atomic_fetch_add((LAS unsigned*)(LC + 16 + i1), 1u, __ATOMIC_RELAXED, __HIP_MEMORY_SCOPE_WORKGROUP);
                        const int pb = (int)__hip_atomic_fetch_add((LAS unsigned*)(LC + 16 + i2), 1u, __ATOMIC_RELAXED, __HIP_MEMORY_SCOPE_WORKGROUP);
                        tok_e[row] = (unsigned)i1 | ((unsigned)i2 << 8); tok_pos[row] = (i32x2){pa, pb}; tok_w[row] = (f32x2){w1, w2}; }
                }
                }
            }
            if (moe) { __syncthreads(); if (tid < 8) cntb[X.vcu * 8 + tid] = (int)LC[16 + tid]; }
        }
        STEP_END;
        if (!moe) {
            if (STEP_ON(10)) {
                PHASE_VARS;
                pg8::Gemm g{(const bf16_t*)(ws + WS_H), (const bf16_t*)(ws + WS_WDEN + (size_t)(l >> 1) * LWD), D, D, D}; pg8::StaticOrder S{T / 256, 2 * FD / 256, X.G, bx_};
                pg8::EpiSwiglu E{(bf16_t*)(ws + WS_HH), FD, 0}; pg8::gemm_phase<pg8::EpiSwiglu, pg8::StaticOrder, true, true>(lds, g, S, E, tid);
            }
            STEP_END;
            if (STEP_ON(11)) {
                PHASE_VARS;
                pg8::Gemm g{(const bf16_t*)(ws + WS_HH), (const bf16_t*)(ws + WS_WDEN + (size_t)(l >> 1) * LWD + SZ_W13D), FD, FD, FD}; pg8::StaticOrder S{T / 256, 4, X.G, bx_};
                pg8::EpiRes E{(bf16_t*)(ws + WS_XR), (const float*)(ws + WS_MOD) + (size_t)l * 5 * 6 * D + 5 * D}; pg8::gemm_phase<pg8::EpiRes, pg8::StaticOrder, true, true>(lds, g, S, E, tid);
            }
            STEP_END;
        } else {
            if (STEP_ON(12)) {
                PHASE_VARS;
                const int* cntb = (const int*)(ws + WS_CNTB); int* meta = (int*)(ws + WS_META);
                const unsigned* tok_e = (const unsigned*)(ws + WS_TOK_E); const i32x2* tok_pos = (const i32x2*)(ws + WS_TOK_POS); i32x2* tok_slot = (i32x2*)(ws + WS_TOK_SLOT);
                const bf16_t* Hb = (const bf16_t*)(ws + WS_H); bf16_t* Xg = (bf16_t*)(ws + WS_XG);
                { const int e = X.wave; int tot = 0, pre = 0;
                  for (int b0 = 0; b0 < X.G; b0 += 64) { const int bb = b0 + lane; const int c = bb < X.G ? cntb[bb * 8 + e] : 0; tot += c; pre += (bb < X.vcu) ? c : 0; }
                  tot = (int)wave_sum((float)tot); pre = (int)wave_sum((float)pre);
                  if (lane == 0) { LC[24 + e] = (unsigned)tot; LC[32 + e] = (unsigned)pre; } }
                __syncthreads();
                if (tid == 0) { int pbase = 0;
                    for (int e = 0; e < 8; ++e) { const int tot = (int)LC[24 + e], np = (tot + 255) >> 8; LC[40 + e] = (unsigned)(pbase * 256 + (int)LC[32 + e]); pbase += np; LC[48 + e] = (unsigned)pbase; } }
                __syncthreads();
                if (X.vcu == 0 && tid < MAXPAN) { int e = 0;
#pragma unroll
                    for (int q = 0; q < 8; ++q) e += ((int)LC[48 + q] <= tid) ? 1 : 0;
                    meta[16 + tid] = e < 8 ? e : 7; if (tid == 0) meta[0] = (int)LC[55]; }
                unsigned een; i32x2 ppn; u32x4 v0n, v1n;
                { const int row0 = X.gw < T ? X.gw : T - 1; een = tok_e[row0]; ppn = tok_pos[row0]; const u32x4* src = (const u32x4*)(Hb + (size_t)row0 * D); v0n = src[lane]; v1n = src[lane + 64]; }
                for (int row = X.gw; row < T; row += X.NGW) {
                    const unsigned ee = een; const i32x2 pp = ppn; const u32x4 v0 = v0n, v1 = v1n;
                    { const int nrow = row + X.NGW; if (nrow < T) { een = tok_e[nrow]; ppn = tok_pos[nrow]; const u32x4* src = (const u32x4*)(Hb + (size_t)nrow * D); v0n = src[lane]; v1n = src[lane + 64]; } }
                    if (last && (row % TPB) < NCTX) continue;
                    const int sa = (int)LC[40 + (ee & 0xff)] + pp.x, sb = (int)LC[40 + ((ee >> 8) & 0xff)] + pp.y;
                    u32x4* da = (u32x4*)(Xg + (size_t)sa * D); u32x4* db = (u32x4*)(Xg + (size_t)sb * D);
                    da[lane] = v0; da[lane + 64] = v1; db[lane] = v0; db[lane + 64] = v1;
                    if (lane == 0) tok_slot[row] = (i32x2){sa, sb};
                }
            }
            STEP_END;
            for (int ch = 0; ch < MOE_NCH; ++ch) {
                if (STEP_ON(13)) {
                    PHASE_VARS;
                    const int* meta = (const int*)(ws + WS_META);
                    const int P = __builtin_amdgcn_readfirstlane(meta[0]); int np = P - ch * MOE_CH; np = np > MOE_CH ? MOE_CH : np;
                    pg8::Gemm g{(const bf16_t*)(ws + WS_XG), (const bf16_t*)(ws + WS_WMOE13), D, D, D}; pg8::MoeOrder S{ch * MOE_CH, np, 2 * FE / 256, X.G, bx_, 0, meta + 16};
                    pg8::EpiSwiglu E{(bf16_t*)(ws + WS_HHG), FE, ch * MOE_CH}; pg8::gemm_phase<pg8::EpiSwiglu, pg8::MoeOrder, true, true>(lds, g, S, E, tid);
                }
                STEP_END;
                if (STEP_ON(14)) {
                    PHASE_VARS;
                    const int* meta = (const int*)(ws + WS_META);
                    const int P = __builtin_amdgcn_readfirstlane(meta[0]); int np = P - ch * MOE_CH; np = np > MOE_CH ? MOE_CH : np;
                    pg8::Gemm g{(const bf16_t*)(ws + WS_HHG), (const bf16_t*)(ws + WS_WMOE2), FE, FE, FE}; pg8::MoeOrder S{ch * MOE_CH, np, 4, X.G, bx_, ch * MOE_CH, meta + 16};
                    pg8::EpiBf16 E{(bf16_t*)(ws + WS_YG), D, 1 << 30, 0}; pg8::gemm_phase<pg8::EpiBf16, pg8::MoeOrder, true, true>(lds, g, S, E, tid);
                }
                STEP_END;
            }
        }
    }
    if (STEP_ON(15)) {
        PHASE_VARS;
        const bf16_t* XR = (const bf16_t*)(ws + WS_XR); const bf16_t* Yg = (const bf16_t*)(ws + WS_YG); const float* modp = (const float*)(ws + WS_MOD);
        const i32x2* tok_slot = (const i32x2*)(ws + WS_TOK_SLOT); const f32x2* tok_w = (const f32x2*)(ws + WS_TOK_W);
        const float* gain = ap->in[IN_FNG]; float* outp = ap->out;
        lds_fill(lds + TL_GAIN, gain, D / 4, tid);
        for (int v = 0; v < 4; ++v) lds_fill(lds + TL_G2 + v * 4096, modp + ((size_t)((DEPTH - 1) * 5 + v) * 6 + 5) * D, D / 4, tid);
        __syncthreads();
        auto next_lat = [&](int row) { while (row < T && (row % TPB) < NCTX) row += X.NGW; return row; };
        u32x2 xn[4]; i32x2 sln; f32x2 wn;
        int row = next_lat(X.gw);
        { const int row0 = row < T ? row : T - 1;
#pragma unroll
            for (int j = 0; j < 4; ++j) xn[j] = ((const u32x2*)(XR + (size_t)row0 * D))[lane + 64 * j];
            sln = tok_slot[row0]; wn = tok_w[row0]; }
        while (row < T) {
            const int b = row / TPB, t = row - b * TPB;
            f32x4 x[4]; const i32x2 sl = sln; const f32x2 w = wn; u32x2 ya[4], yb[4];
#pragma unroll
            for (int j = 0; j < 4; ++j) { x[j] = bf4(xn[j]); ya[j] = ((const u32x2*)(Yg + (size_t)sl.x * D))[lane + 64 * j]; yb[j] = ((const u32x2*)(Yg + (size_t)sl.y * D))[lane + 64 * j]; }
            const int nrow = next_lat(row + X.NGW);
            if (nrow < T) {
#pragma unroll
                for (int j = 0; j < 4; ++j) xn[j] = ((const u32x2*)(XR + (size_t)nrow * D))[lane + 64 * j];
                sln = tok_slot[nrow]; wn = tok_w[nrow]; }
            { const LAS f32x4* g2 = (const LAS f32x4*)(lds + TL_G2 + b * 4096);
#pragma unroll
              for (int j = 0; j < 4; ++j) { const f32x4 g = g2[lane + 64 * j];
                  x[j][0] += g[0] * (w.x * bflo(ya[j].x) + w.y * bflo(yb[j].x)); x[j][1] += g[1] * (w.x * bfhi(ya[j].x) + w.y * bfhi(yb[j].x));
                  x[j][2] += g[2] * (w.x * bflo(ya[j].y) + w.y * bflo(yb[j].y)); x[j][3] += g[3] * (w.x * bfhi(ya[j].y) + w.y * bfhi(yb[j].y)); } }
            float ss = 0.f;
#pragma unroll
            for (int j = 0; j < 4; ++j) ss += (x[j][0] * x[j][0] + x[j][1] * x[j][1]) + (x[j][2] * x[j][2] + x[j][3] * x[j][3]);
            const float rstd = 1.0f / sqrtf(wave_sum(ss) * (1.0f / D) + EPS);
            float* orow = outp + ((size_t)b * SEQ + (t - NCTX)) * D;
#pragma unroll
            for (int j = 0; j < 4; ++j) { const f32x4 g = ((const LAS f32x4*)(lds + TL_GAIN))[lane + 64 * j]; ((f32x4*)orow)[lane + 64 * j] = x[j] * rstd * g; }
            row = nrow;
        }
    }
    STEP_END;
#undef STEP_ON
#undef STEP_END
#undef PHASE_VARS
}

constexpr int NSTEPS = 1 + DEPTH * 7 + 2 * 2 + 2 * (1 + 2 * MOE_NCH) + 1;
extern "C" void kernel_launch(void* const* d_in, const int* in_sizes, int n_in, void* d_out, int out_size, void* d_ws, size_t ws_size, hipStream_t stream) {
    static int grid = 0;
    if (grid == 0) {
        if (n_in != 26 || in_sizes[0] != NB * SEQ * D || out_size != NB * SEQ * D || ws_size < WS_END) {
            fprintf(stderr, "kernel_launch: shape mismatch: n_in %d in0 %d out %d ws %zu (need >= %zu)\n", n_in, n_in > 0 ? in_sizes[0] : -1, out_size, ws_size, (size_t)WS_END); grid = -1; return; }
        int dev = 0, cus = 0, per_cu = 0;
        if (hipGetDevice(&dev) != hipSuccess || hipDeviceGetAttribute(&cus, hipDeviceAttributeMultiprocessorCount, dev) != hipSuccess) { fprintf(stderr, "kernel_launch: device query failed\n"); grid = -1; return; }
        if (hipFuncSetAttribute((const void*)mega_fwd, hipFuncAttributeMaxDynamicSharedMemorySize, LDS_BYTES) != hipSuccess) { fprintf(stderr, "kernel_launch: hipFuncSetAttribute failed\n"); grid = -1; return; }
        if (hipOccupancyMaxActiveBlocksPerMultiprocessor(&per_cu, (const void*)mega_fwd, 512, LDS_BYTES) != hipSuccess || per_cu < 1)
            fprintf(stderr, "kernel_launch: note: occupancy query reports %d workgroups per CU\n", per_cu);
        (void)hipGetLastError();
        grid = cus;
    }
    if (grid < 0) return;
    if (hipMemsetAsync((char*)d_ws + WS_CTL, 0, CTL_ZERO_BYTES, stream) != hipSuccess) { fprintf(stderr, "kernel_launch: memset failed\n"); return; }
    Args a{};
    for (int i = 0; i < 26; ++i) a.in[i] = (const float*)d_in[i];
    a.out = (float*)d_out; a.ws = (unsigned char*)d_ws;
    for (int f = 0; f < 8; ++f) a.inv_mla[f] = powf(10000.0f, -((float)f * 2.0f) / 16.0f);
    for (int f = 0; f < 16; ++f) a.inv_gqa[f] = powf(10000.0f, -((float)f * 2.0f) / 32.0f);
#if MK_MULTI
    for (int s = 0; s < NSTEPS; ++s) { a.ph_lo = s; a.ph_hi = s + 1; hipLaunchKernelGGL(mega_fwd, dim3(grid), dim3(512), LDS_BYTES, stream, a); }
#else
    a.ph_lo = 0; a.ph_hi = NSTEPS;
    hipLaunchKernelGGL(mega_fwd, dim3(grid), dim3(512), LDS_BYTES, stream, a);
#endif
    const hipError_t le = hipPeekAtLastError();
    if (le != hipSuccess) fprintf(stderr, "kernel_launch: launch failed: %s\n", hipGetErrorName(le));
}
```
